# Optimizing an MI355X kernel written in HIP

```python
import math
import jax, jax.numpy as jnp
from jax import lax
import numpy as np

D_MODEL = 4096
BATCH = 1
SEQ = 8192
DEPTH = 2

HEAD_DIM = 128
N_HEADS_TOTAL = D_MODEL // HEAD_DIM
N_HEADS_A = N_HEADS_TOTAL // 2
N_KV_A = N_HEADS_A // 4
N_HEADS_B = N_HEADS_TOTAL - N_HEADS_A
WIDTH_A = N_HEADS_A * HEAD_DIM
WIDTH_B = N_HEADS_B * HEAD_DIM
KV_WIDTH_A = N_KV_A * HEAD_DIM
MIX_WIDTH = WIDTH_A + WIDTH_B
IN_COLS = WIDTH_A + 2 * KV_WIDTH_A + 3 * WIDTH_B
GRID_W = 64
WIN_H_MAX = 8
WIN_W = 16
MEM_LEN = 256
N_HEADS_MEM = 4
MEM_WIDTH = N_HEADS_MEM * HEAD_DIM
D_FF = 256 * ((8 * D_MODEL // 3 + 255) // 256)
ROPE_THETA = 10000.0
EPS = 1e-6
Q_BLOCK = 128

kernel_name = "hybrid_gqa_natten_macaron_encoder"


def rms_norm(x, g):
    xf = x.astype(jnp.float32)
    y = xf * lax.rsqrt(jnp.mean(xf * xf, axis=-1, keepdims=True) + EPS)
    return (y * g.astype(jnp.float32)).astype(x.dtype)


def swiglu(h, w_gate, w_up, w_down):
    return (jax.nn.silu(h @ w_gate) * (h @ w_up)) @ w_down


def axial_rope_tables(seq_len):
    t = jnp.arange(seq_len)
    row = (t // GRID_W).astype(jnp.float32)
    col = (t % GRID_W).astype(jnp.float32)
    axis_dim = HEAD_DIM // 2
    inv_freq = ROPE_THETA ** (-jnp.arange(0, axis_dim, 2, dtype=jnp.float32) / axis_dim)
    ang = jnp.concatenate([row[:, None] * inv_freq, col[:, None] * inv_freq], axis=-1)
    return jnp.cos(ang), jnp.sin(ang)


def apply_axial_rope(x, cos, sin):
    S = x.shape[1]
    nf = HEAD_DIM // 4
    xs = x.astype(jnp.float32).reshape(*x.shape[:-1], 2, 2, nf)
    x1, x2 = xs[..., 0, :], xs[..., 1, :]
    c = cos.reshape(S, 1, 2, nf)
    s = sin.reshape(S, 1, 2, nf)
    out = jnp.stack([x1 * c - x2 * s, x2 * c + x1 * s], axis=-2)
    return out.reshape(x.shape).astype(x.dtype)


def global_gqa(q, k, v):
    B, S, _, D = q.shape
    G = N_HEADS_A // N_KV_A
    nblk = S // Q_BLOCK
    qb = q.reshape(B, nblk, Q_BLOCK, N_KV_A, G, D).transpose(1, 0, 2, 3, 4, 5)
    scale = D ** -0.5

    def block(qblk):
        s = jnp.einsum('bqkgd,bskd->bkgqs', qblk, k, preferred_element_type=jnp.float32) * scale
        p = jax.nn.softmax(s, axis=-1).astype(v.dtype)
        return jnp.einsum('bkgqs,bskd->bqkgd', p, v)

    o = lax.map(block, qb)
    return o.transpose(1, 0, 2, 3, 4, 5).reshape(B, S, N_HEADS_A * D)


def neighbourhood_attn(q, k, v, rpb):
    B, S, H, D = q.shape
    rows = S // GRID_W
    kh = min(WIN_H_MAX, rows)
    qg = q.reshape(B, rows, GRID_W, H, D).transpose(1, 0, 2, 3, 4)
    kg = k.reshape(B, rows, GRID_W, H, D)
    vg = v.reshape(B, rows, GRID_W, H, D)
    cols = jnp.arange(GRID_W)
    col_start = jnp.clip(cols - WIN_W // 2, 0, GRID_W - WIN_W)
    col_idx = col_start[:, None] + jnp.arange(WIN_W)
    col_bias_idx = col_idx - cols[:, None] + (WIN_W - 1)
    rpb_cols = rpb[:, :, col_bias_idx]
    scale = D ** -0.5

    def row_block(args):
        i, qi = args
        rs = jnp.clip(i - kh // 2, 0, rows - kh)
        kr = lax.dynamic_slice_in_dim(kg, rs, kh, axis=1)
        vr = lax.dynamic_slice_in_dim(vg, rs, kh, axis=1)
        kn = kr[:, :, col_idx]
        vn = vr[:, :, col_idx]
        row_off = rs + jnp.arange(kh) - i + (WIN_H_MAX - 1)
        bias = jnp.take(rpb_cols, row_off, axis=1).transpose(0, 2, 1, 3)
        s = jnp.einsum('bqhd,baqkhd->bhqak', qi, kn, preferred_element_type=jnp.float32) * scale
        s = s + bias[None].astype(jnp.float32)
        p = jax.nn.softmax(s.reshape(B, H, GRID_W, kh * WIN_W), axis=-1)
        p = p.reshape(s.shape).astype(v.dtype)
        return jnp.einsum('bhqak,baqkhd->bqhd', p, vn)

    o = lax.map(row_block, (jnp.arange(rows), qg))
    return o.transpose(1, 0, 2, 3, 4).reshape(B, S, H * D)


def hybrid_mixer(h, w_in, q_norm_a, k_norm_a, rpb_b, out_norm_a, out_norm_b, w_out, cos, sin):
    B, S, _ = h.shape
    proj = h @ w_in
    c0 = WIDTH_A
    c1 = c0 + KV_WIDTH_A
    c2 = c1 + KV_WIDTH_A
    c3 = c2 + WIDTH_B
    c4 = c3 + WIDTH_B
    qa, ka, va, qb, kb, vb = jnp.split(proj, [c0, c1, c2, c3, c4], axis=-1)
    qa = qa.reshape(B, S, N_HEADS_A, HEAD_DIM)
    ka = ka.reshape(B, S, N_KV_A, HEAD_DIM)
    va = va.reshape(B, S, N_KV_A, HEAD_DIM)
    qa = apply_axial_rope(rms_norm(qa, q_norm_a), cos, sin)
    ka = apply_axial_rope(rms_norm(ka, k_norm_a), cos, sin)
    oa = global_gqa(qa, ka, va)
    ob = neighbourhood_attn(qb.reshape(B, S, N_HEADS_B, HEAD_DIM),
                            kb.reshape(B, S, N_HEADS_B, HEAD_DIM),
                            vb.reshape(B, S, N_HEADS_B, HEAD_DIM), rpb_b)
    o = jnp.concatenate([rms_norm(oa, out_norm_a), rms_norm(ob, out_norm_b)], axis=-1)
    return o @ w_out


def memory_xattn(h, m, wq, wkv, wo):
    B, S, _ = h.shape
    M = m.shape[1]
    q = (h @ wq).reshape(B, S, N_HEADS_MEM, HEAD_DIM)
    k, v = jnp.split(m @ wkv, 2, axis=-1)
    k = k.reshape(B, M, N_HEADS_MEM, HEAD_DIM)
    v = v.reshape(B, M, N_HEADS_MEM, HEAD_DIM)
    s = jnp.einsum('bqhd,bmhd->bhqm', q, k, preferred_element_type=jnp.float32) * (HEAD_DIM ** -0.5)
    p = jax.nn.softmax(s, axis=-1).astype(v.dtype)
    o = jnp.einsum('bhqm,bmhd->bqhd', p, v).reshape(B, S, MEM_WIDTH)
    return o @ wo


def setup_inputs(seed: int = 0) -> dict:
    key = jax.random.key(seed)
    ks = jax.random.split(key, 24)

    def w(k, shape, fan_in):
        return jax.random.normal(k, shape, jnp.float32) * (fan_in ** -0.5)

    def gain(k, shape):
        return 1.0 + 0.05 * jax.random.normal(k, shape, jnp.float32)

    L = DEPTH
    return {
        "x": jax.random.normal(ks[0], (BATCH, SEQ, D_MODEL), jnp.float32),
        "mem": jax.random.normal(ks[1], (BATCH, MEM_LEN, D_MODEL), jnp.float32),
        "ffn1_norm": gain(ks[2], (L, D_MODEL)),
        "ffn1_w_gate": w(ks[3], (L, D_MODEL, D_FF), D_MODEL),
        "ffn1_w_up": w(ks[4], (L, D_MODEL, D_FF), D_MODEL),
        "ffn1_w_down": w(ks[5], (L, D_FF, D_MODEL), D_FF),
        "mix_norm": gain(ks[6], (L, D_MODEL)),
        "w_in": w(ks[7], (L, D_MODEL, IN_COLS), D_MODEL),
        "q_norm_a": gain(ks[8], (L, HEAD_DIM)),
        "k_norm_a": gain(ks[9], (L, HEAD_DIM)),
        "rpb_b": 0.1 * jax.random.normal(ks[10], (L, N_HEADS_B, 2 * WIN_H_MAX - 1, 2 * WIN_W - 1), jnp.float32),
        "out_norm_a": gain(ks[11], (L, WIDTH_A)),
        "out_norm_b": gain(ks[12], (L, WIDTH_B)),
        "w_out": w(ks[13], (L, MIX_WIDTH, D_MODEL), MIX_WIDTH),
        "xattn_norm": gain(ks[14], (L, D_MODEL)),
        "mem_norm": gain(ks[15], (L, D_MODEL)),
        "xattn_wq": w(ks[16], (L, D_MODEL, MEM_WIDTH), D_MODEL),
        "xattn_wkv": w(ks[17], (L, D_MODEL, 2 * MEM_WIDTH), D_MODEL),
        "xattn_wo": w(ks[18], (L, MEM_WIDTH, D_MODEL), MEM_WIDTH),
        "ffn2_norm": gain(ks[19], (L, D_MODEL)),
        "ffn2_w_gate": w(ks[20], (L, D_MODEL, D_FF), D_MODEL),
        "ffn2_w_up": w(ks[21], (L, D_MODEL, D_FF), D_MODEL),
        "ffn2_w_down": w(ks[22], (L, D_FF, D_MODEL), D_FF),
        "final_norm": gain(ks[23], (D_MODEL,)),
    }


def reference(x, mem, ffn1_norm, ffn1_w_gate, ffn1_w_up, ffn1_w_down, mix_norm, w_in,
              q_norm_a, k_norm_a, rpb_b, out_norm_a, out_norm_b, w_out,
              xattn_norm, mem_norm, xattn_wq, xattn_wkv, xattn_wo,
              ffn2_norm, ffn2_w_gate, ffn2_w_up, ffn2_w_down, final_norm):
    cos, sin = axial_rope_tables(x.shape[1])
    for l in range(DEPTH):
        h = rms_norm(x, ffn1_norm[l])
        x = x + 0.5 * swiglu(h, ffn1_w_gate[l], ffn1_w_up[l], ffn1_w_down[l])
        h = rms_norm(x, mix_norm[l])
        x = x + hybrid_mixer(h, w_in[l], q_norm_a[l], k_norm_a[l], rpb_b[l],
                             out_norm_a[l], out_norm_b[l], w_out[l], cos, sin)
        h = rms_norm(x, xattn_norm[l])
        m = rms_norm(mem, mem_norm[l])
        x = x + memory_xattn(h, m, xattn_wq[l], xattn_wkv[l], xattn_wo[l])
        h = rms_norm(x, ffn2_norm[l])
        x = x + 0.5 * swiglu(h, ffn2_w_gate[l], ffn2_w_up[l], ffn2_w_down[l])
    return rms_norm(x, final_norm)
```

```cpp
#include <hip/hip_runtime.h>
#include <cstdio>
#include <cstdint>
__device__ __forceinline__ int opaque_tid() { int t = (int)threadIdx.x; asm volatile("" : "+v"(t)); return t; }
namespace pg8 {
#define PG8_LAS __attribute__((address_space(3)))
typedef unsigned short bf16_t;
typedef short bf16x8 __attribute__((ext_vector_type(8)));
typedef float f32x4 __attribute__((ext_vector_type(4)));
typedef unsigned u32x4 __attribute__((ext_vector_type(4)));
constexpr int BM = 256, BK = 64, HALF = 128, HTB = HALF * BK * 2  , STAGE_BYTES = 8 * HTB, NXCD = 8, WGM = 8;

__host__ __device__ __forceinline__ int lds_byte(int r, int c) { const int st = (r >> 4) * 2 + (c >> 5), rr = r & 15, cc = c & 31, ob = rr * 64 + cc * 2; return st * 1024 + (ob ^ (((ob >> 9) & 1) << 5)); }
__host__ __device__ __forceinline__ void stage_rc(int b, int& R, int& C) { const int st = b / 1024, sb = b % 1024, swz = sb ^ (((sb >> 9) & 1) << 5); R = (st >> 1) * 16 + swz / 64; C = (st & 1) * 32 + (swz % 64) / 2; }
__host__ __device__ __forceinline__ int perm32(int rho) { const int n = rho >> 4, i = rho & 15; return 8 * (i >> 2) + 4 * n + (i & 3); }

struct Unit { int pm, pn; };
struct Gemm { const bf16_t* A; const bf16_t* Bt; int M, N, K; };

struct StaticOrder {
    int nM, nN, nwg, G, c;
    __host__ __device__ void init(int M, int N, int G_, int c_) { nM = M / BM; nN = N / BM; nwg = nM * nN; G = G_; c = c_; }
    __host__ __device__ bool next(int i, Unit& u) const {
        const long L = (long)i * G + c; if (L >= nwg) return false;
        int wgid = (int)L; { const int q = nwg / NXCD, r = nwg % NXCD, xcd = wgid % NXCD, off = wgid / NXCD; wgid = (xcd < r ? xcd * (q + 1) : r * (q + 1) + (xcd - r) * q) + off; }
        const int nig = WGM * nN, gid = wgid / nig, fm = gid * WGM, gsz = (nM - fm) < WGM ? (nM - fm) : WGM;
        u.pm = fm + ((wgid % nig) % gsz); u.pn = (wgid % nig) / gsz; return true;
    }
    __device__ __forceinline__ void a_ready(const Unit&) const {}
    __device__ __forceinline__ void done(const Unit&) const {}
};
__device__ __forceinline__ unsigned cvt_pk_bf16(float lo, float hi) { unsigned r; asm volatile("v_cvt_pk_bf16_f32 %0, %1, %2" : "=v"(r) : "v"(lo), "v"(hi)); return r; }
typedef float f32x2 __attribute__((ext_vector_type(2)));
struct EpiBf16 {
    static constexpr bool PERM = true, AFTER_DRAIN = false;
    bf16_t* O; int ldc;
    __device__ __forceinline__ void operator()(const f32x4 (&acc)[2][2][4][2], const Unit& u, int wr, int wc, int fr, int fq) const {
        const int row0 = u.pm * BM + wr * 64 + fr, col0 = u.pn * BM + wc * 32 + 8 * fq;
#pragma unroll
        for (int ai = 0; ai < 2; ++ai)
#pragma unroll
            for (int m = 0; m < 4; ++m) { bf16_t* rowp = O + (size_t)(row0 + ai * HALF + m * 16) * ldc + col0;
#pragma unroll
                for (int bj = 0; bj < 2; ++bj) { const f32x4 v0 = acc[ai][bj][m][0], v1 = acc[ai][bj][m][1];
                    u32x4 w; w.x = cvt_pk_bf16(v0[0], v0[1]); w.y = cvt_pk_bf16(v0[2], v0[3]); w.z = cvt_pk_bf16(v1[0], v1[1]); w.w = cvt_pk_bf16(v1[2], v1[3]);
                    *(u32x4*)(rowp + bj * HALF) = w; } }
    }
};
__device__ __forceinline__ float silu_mul(float g, float u) { const float e = __builtin_amdgcn_exp2f(g * -1.4426950408889634f); return g * __builtin_amdgcn_rcpf(1.0f + e) * u; }
struct EpiSwiglu {
    static constexpr bool PERM = true, AFTER_DRAIN = false;
    bf16_t* O; int ldc;
    __device__ __forceinline__ void operator()(const f32x4 (&acc)[2][2][4][2], const Unit& u, int wr, int wc, int fr, int fq) const {
        const int row0 = u.pm * BM + wr * 64 + fr, col0 = u.pn * HALF + wc * 32 + 8 * fq;
#pragma unroll
        for (int ai = 0; ai < 2; ++ai)
#pragma unroll
            for (int m = 0; m < 4; ++m) { bf16_t* rowp = O + (size_t)(row0 + ai * HALF + m * 16) * ldc + col0;
                const f32x4 g0 = acc[ai][0][m][0], g1 = acc[ai][0][m][1], u0 = acc[ai][1][m][0], u1 = acc[ai][1][m][1];
                u32x4 w; w.x = cvt_pk_bf16(silu_mul(g0[0], u0[0]), silu_mul(g0[1], u0[1])); w.y = cvt_pk_bf16(silu_mul(g0[2], u0[2]), silu_mul(g0[3], u0[3]));
                w.z = cvt_pk_bf16(silu_mul(g1[0], u1[0]), silu_mul(g1[1], u1[1])); w.w = cvt_pk_bf16(silu_mul(g1[2], u1[2]), silu_mul(g1[3], u1[3]));
                *(u32x4*)rowp = w; }
    }
};
struct EpiResid {
    static constexpr bool PERM = false, AFTER_DRAIN = false;
    const float* base; float* out; int ldc; float alpha;
    __device__ __forceinline__ void operator()(const f32x4 (&acc)[2][2][4][2], const Unit& u, int wr, int wc, int fr, int fq) const {
        const int row0 = u.pm * BM + wr * 64 + fr, col0 = u.pn * BM + wc * 32 + 4 * fq;
#pragma unroll
        for (int ai = 0; ai < 2; ++ai)
#pragma unroll
            for (int m = 0; m < 4; ++m) { const size_t off = (size_t)(row0 + ai * HALF + m * 16) * ldc + col0;
#pragma unroll
                for (int bj = 0; bj < 2; ++bj)
#pragma unroll
                    for (int n = 0; n < 2; ++n) { const f32x4 bs = *(const f32x4*)(base + off + bj * HALF + n * 16); *(f32x4*)(out + off + bj * HALF + n * 16) = bs + acc[ai][bj][m][n] * alpha; } }
    }
};
template <class Epi, class Sched, bool ALIGN_EPI = false, bool SP2 = false>
__device__ __forceinline__ void gemm_phase(PG8_LAS unsigned char* lds, const Gemm g, const Sched& S, const Epi& E) {
    const int tid = opaque_tid(), wid = __builtin_amdgcn_readfirstlane(tid >> 6), lane = tid & 63, wr = wid >> 2, wc = wid & 3, fr = lane & 15, fq = lane >> 4;
    const int K = g.K, nt = K / BK;
    unsigned voffA[2], voffB[2];
#pragma unroll
    for (int i = 0; i < 2; ++i) { int R, C; stage_rc(tid * 16 + i * 8192, R, C); const int Rb = Epi::PERM ? ((R & ~31) + perm32(R & 31)) : R;
        voffA[i] = (unsigned)(R * K + C) * 2u; voffB[i] = (unsigned)(Rb * K + C) * 2u; }
    const size_t kstep = (size_t)(BK * 2);
    const size_t hstep = (size_t)HALF * K * 2;
    const size_t tstep = 2 * hstep;
    const unsigned ldsw = (unsigned)wid * 1024u;
    const int aoff = lds_byte(wr * 64 + fr, fq * 8), boff = lds_byte(wc * 32 + fr, fq * 8);
#define PG8_SA(b, h) (((b) * 2 + (h)) * HTB)
#define PG8_SB(b, h) ((4 + (b) * 2 + (h)) * HTB)
#define PG8_STAGE(bufoff, gbase, voff) do { _Pragma("unroll") for (int _i = 0; _i < 2; ++_i) \
        __builtin_amdgcn_global_load_lds((const unsigned*)((const char*)(gbase) + (voff)[_i]), (PG8_LAS unsigned*)(lds + (bufoff) + ldsw + _i * 8192), 16, 0, 0); } while (0)
#define PG8_LDA(dst, b, h) do { _Pragma("unroll") for (int m = 0; m < 4; ++m) _Pragma("unroll") for (int k = 0; k < 2; ++k) dst[m][k] = *(const PG8_LAS bf16x8*)(lds + PG8_SA(b, h) + aoff + m * 2048 + k * 1024); } while (0)
#define PG8_LDB(dst, b, h) do { _Pragma("unroll") for (int n = 0; n < 2; ++n) _Pragma("unroll") for (int k = 0; k < 2; ++k) dst[n][k] = *(const PG8_LAS bf16x8*)(lds + PG8_SB(b, h) + boff + n * 2048 + k * 1024); } while (0)
#define PG8_MMA(ai, bj, At, Bt) do { __builtin_amdgcn_s_setprio(1); _Pragma("unroll") for (int m = 0; m < 4; ++m) _Pragma("unroll") for (int n = 0; n < 2; ++n) _Pragma("unroll") for (int k = 0; k < 2; ++k) \
        acc[ai][bj][m][n] = __builtin_amdgcn_mfma_f32_16x16x32_bf16(Bt[n][k], At[m][k], acc[ai][bj][m][n], 0, 0, 0); __builtin_amdgcn_s_setprio(0); } while (0)
#define PG8_WAIT_V(n) asm volatile("s_waitcnt vmcnt(" #n ")" ::: "memory")
#define PG8_WAIT_L(n) asm volatile("s_waitcnt lgkmcnt(" #n ")" ::: "memory")
#define PG8_BAR __builtin_amdgcn_s_barrier()
#define PG8_SCHED __builtin_amdgcn_sched_barrier(0)
    Unit cur, nxt; int ui = 0;
    if (!S.next(0, cur)) return;
    f32x4 acc[2][2][4][2];
#pragma unroll
    for (int a = 0; a < 2; ++a)
#pragma unroll
        for (int b = 0; b < 2; ++b)
#pragma unroll
            for (int m = 0; m < 4; ++m)
#pragma unroll
                for (int n = 0; n < 2; ++n) acc[a][b][m][n] = (f32x4){0.f, 0.f, 0.f, 0.f};
    bf16x8 At[4][2], B0[2][2], B1[2][2];
    const char* cA = (const char*)g.A + (size_t)cur.pm * tstep; const char* cB = (const char*)g.Bt + (size_t)cur.pn * tstep;
    S.a_ready(cur);
    if constexpr (SP2) {
        PG8_STAGE(PG8_SB(0, 0), cB, voffB); PG8_STAGE(PG8_SB(0, 1), cB + hstep, voffB); PG8_STAGE(PG8_SA(0, 0), cA, voffA); PG8_STAGE(PG8_SA(0, 1), cA + hstep, voffA);
        if (wr == 1) PG8_BAR;
        PG8_WAIT_V(2); PG8_BAR;
        PG8_STAGE(PG8_SB(1, 0), cB + kstep, voffB); PG8_STAGE(PG8_SA(1, 0), cA + kstep, voffA); PG8_STAGE(PG8_SB(1, 1), cB + hstep + kstep, voffB);
        PG8_WAIT_V(6); PG8_BAR;
    } else {
        PG8_STAGE(PG8_SB(0, 0), cB, voffB); PG8_STAGE(PG8_SA(0, 0), cA, voffA); PG8_STAGE(PG8_SB(0, 1), cB + hstep, voffB); PG8_STAGE(PG8_SA(0, 1), cA + hstep, voffA);
        if (wr == 1) PG8_BAR;
        PG8_WAIT_V(4); PG8_BAR;
        PG8_STAGE(PG8_SB(1, 0), cB + kstep, voffB); PG8_STAGE(PG8_SA(1, 0), cA + kstep, voffA); PG8_STAGE(PG8_SB(1, 1), cB + hstep + kstep, voffB);
        PG8_WAIT_V(6); PG8_BAR;
    }
    for (;;) {
        const bool has_next = S.next(ui + 1, nxt);
        const char* nA = has_next ? (const char*)g.A + (size_t)nxt.pm * tstep : cA; const char* nB = has_next ? (const char*)g.Bt + (size_t)nxt.pn * tstep : cB;
        for (int t = 0; t < nt; t += 2) {
            const bool last = (t == nt - 2);
            const char* a1 = cA + (size_t)(t + 1) * kstep;
            const char* a2 = last ? nA : cA + (size_t)(t + 2) * kstep; const char* b2 = last ? nB : cB + (size_t)(t + 2) * kstep;
            const char* a3 = a2 + kstep; const char* b3 = b2 + kstep;
            if (last && has_next) S.a_ready(nxt);
            if constexpr (SP2) {
            PG8_LDB(B0, 0, 0); PG8_LDB(B1, 0, 1); PG8_SCHED; PG8_LDA(At, 0, 0); PG8_STAGE(PG8_SA(1, 1), a1 + hstep, voffA);
            PG8_WAIT_V(8); PG8_WAIT_L(0); PG8_BAR; PG8_MMA(0, 0, At, B0); PG8_MMA(0, 1, At, B1); PG8_BAR; PG8_SCHED;
            PG8_LDA(At, 0, 1); PG8_STAGE(PG8_SB(0, 0), b2, voffB); PG8_STAGE(PG8_SB(0, 1), b2 + hstep, voffB); PG8_STAGE(PG8_SA(0, 0), a2, voffA);
            PG8_WAIT_V(8); PG8_WAIT_L(0); PG8_BAR; PG8_MMA(1, 0, At, B0); PG8_MMA(1, 1, At, B1); PG8_BAR; PG8_SCHED;
            PG8_LDB(B0, 1, 0); PG8_LDB(B1, 1, 1); PG8_SCHED; PG8_LDA(At, 1, 0); PG8_STAGE(PG8_SA(0, 1), a2 + hstep, voffA);
            PG8_WAIT_V(8); PG8_WAIT_L(0); PG8_BAR; PG8_MMA(0, 0, At, B0); PG8_MMA(0, 1, At, B1); PG8_BAR; PG8_SCHED;
            PG8_LDA(At, 1, 1); PG8_STAGE(PG8_SB(1, 0), b3, voffB); PG8_STAGE(PG8_SB(1, 1), b3 + hstep, voffB); PG8_STAGE(PG8_SA(1, 0), a3, voffA);
            PG8_WAIT_V(8); PG8_WAIT_L(0); PG8_BAR; PG8_MMA(1, 0, At, B0); PG8_MMA(1, 1, At, B1); PG8_BAR; PG8_SCHED;
            } else {
            PG8_LDB(B0, 0, 0); PG8_SCHED; PG8_LDA(At, 0, 0); PG8_STAGE(PG8_SA(1, 1), a1 + hstep, voffA);
            PG8_WAIT_L(8); PG8_BAR; PG8_WAIT_L(0); PG8_MMA(0, 0, At, B0); PG8_BAR; PG8_SCHED;
            PG8_LDB(B1, 0, 1); PG8_STAGE(PG8_SB(0, 0), b2, voffB);
            PG8_BAR; PG8_WAIT_L(0); PG8_MMA(0, 1, At, B1); PG8_BAR;
            PG8_LDA(At, 0, 1); PG8_STAGE(PG8_SA(0, 0), a2, voffA);
            PG8_BAR; PG8_WAIT_L(0); PG8_MMA(1, 0, At, B0); PG8_BAR; PG8_SCHED;
            PG8_STAGE(PG8_SB(0, 1), b2 + hstep, voffB);
            PG8_WAIT_V(6); PG8_BAR; PG8_MMA(1, 1, At, B1); PG8_BAR;
            PG8_LDB(B0, 1, 0); PG8_SCHED; PG8_LDA(At, 1, 0); PG8_STAGE(PG8_SA(0, 1), a2 + hstep, voffA);
            PG8_WAIT_L(8); PG8_BAR; PG8_WAIT_L(0); PG8_MMA(0, 0, At, B0); PG8_BAR; PG8_SCHED;
            PG8_LDB(B1, 1, 1); PG8_STAGE(PG8_SB(1, 0), b3, voffB);
            PG8_BAR; PG8_WAIT_L(0); PG8_MMA(0, 1, At, B1); PG8_BAR;
            PG8_LDA(At, 1, 1); PG8_STAGE(PG8_SA(1, 0), a3, voffA);
            PG8_BAR; PG8_WAIT_L(0); PG8_MMA(1, 0, At, B0); PG8_BAR; PG8_SCHED;
            PG8_STAGE(PG8_SB(1, 1), b3 + hstep, voffB);
            PG8_WAIT_V(6); PG8_BAR; PG8_MMA(1, 1, At, B1); PG8_BAR;
            }
        }
        if constexpr (ALIGN_EPI) { if (wr == 0) PG8_BAR; }
        if constexpr (!Epi::AFTER_DRAIN) { E(acc, cur, wr, wc, fr, fq); S.done(cur); }
        if (!has_next) break;
#pragma unroll
        for (int a = 0; a < 2; ++a)
#pragma unroll
            for (int b = 0; b < 2; ++b)
#pragma unroll
                for (int m = 0; m < 4; ++m)
#pragma unroll
                    for (int n = 0; n < 2; ++n) acc[a][b][m][n] = (f32x4){0.f, 0.f, 0.f, 0.f};
        cur = nxt; cA = nA; cB = nB; ++ui;
        if constexpr (ALIGN_EPI) { if (wr == 1) PG8_BAR; }
    }
    PG8_WAIT_V(0);
    if constexpr (!ALIGN_EPI) { if (wr == 0) PG8_BAR; }
    PG8_BAR;
    if constexpr (Epi::AFTER_DRAIN) { E.fused(acc, cur, wr, wc, fr, fq, lds, wid, lane); S.done(cur); }
#undef PG8_SA
#undef PG8_SB
#undef PG8_STAGE
#undef PG8_LDA
#undef PG8_LDB
#undef PG8_MMA
#undef PG8_WAIT_V
#undef PG8_WAIT_L
#undef PG8_BAR
#undef PG8_SCHED
}
}
namespace att {
typedef unsigned short bf16;
constexpr int   D = 128, NW = 8, QBLK = 32, KVBLK = 64;
constexpr float SCALE = 0.088388347648318440f;
constexpr float THR = 8.f;
constexpr size_t SHM_V = KVBLK * D * 2, SHM_K = KVBLK * D * 2, SHM_ATTN = 2 * SHM_V + 2 * SHM_K + NW * 64 * 4;
using bf16x8 = __attribute__((ext_vector_type(8))) short;
using s16x4  = __attribute__((ext_vector_type(4))) short;
using f32x16 = __attribute__((ext_vector_type(16))) float;
using u32x4  = __attribute__((ext_vector_type(4))) unsigned;
#define KSWZ(row, colB) ((row) * 256 + ((colB) ^ (((row) & 7) << 4)))
#define SBAR() __builtin_amdgcn_sched_barrier(0)
__device__ __forceinline__ int crow(int r, int hi) { return (r & 3) + 8 * (r >> 2) + 4 * hi; }
__device__ __forceinline__ unsigned cvtpk(float lo, float hi) {
  unsigned r; asm volatile("v_cvt_pk_bf16_f32 %0, %1, %2" : "=v"(r) : "v"(lo), "v"(hi)); return r;
}
__device__ __forceinline__ bf16x8 ld8(const bf16* p) { return *reinterpret_cast<const bf16x8*>(p); }

__device__ __forceinline__ void partialSM(f32x16& p0, f32x16& p1, float& m_reg, float& mn, float& alpha) {
  constexpr float C = SCALE * 1.4426950408889634f;
  float pmax = p0[0]; for (int r = 1; r < 16; ++r) pmax = fmaxf(pmax, p0[r]); for (int r = 0; r < 16; ++r) pmax = fmaxf(pmax, p1[r]);
  { auto rr = __builtin_amdgcn_permlane32_swap(__float_as_uint(pmax), __float_as_uint(pmax), false, false);
    pmax = fmaxf(__uint_as_float(rr[0]), __uint_as_float(rr[1])); }
  if (__builtin_expect(__all(pmax - m_reg <= THR / SCALE), 1)) { mn = m_reg; alpha = 1.f; }
  else { mn = fmaxf(m_reg, pmax); alpha = __builtin_amdgcn_exp2f((m_reg - mn) * C); m_reg = mn; }
  float mnC = -mn * C;
  for (int r = 0; r < 16; ++r) p0[r] = fmaf(p0[r], C, mnC); for (int r = 0; r < 16; ++r) p1[r] = fmaf(p1[r], C, mnC);
  for (int r = 0; r < 16; ++r) p0[r] = __builtin_amdgcn_exp2f(p0[r]);
}
__device__ __forceinline__ void finishSM(f32x16& p0, f32x16& p1, float alpha, float& l_reg, bf16x8& pa0, bf16x8& pa1, bf16x8& pa2, bf16x8& pa3) {
  for (int r = 0; r < 16; ++r) p1[r] = __builtin_amdgcn_exp2f(p1[r]);
  float ps = 0; for (int r = 0; r < 16; ++r) ps += p0[r]; for (int r = 0; r < 16; ++r) ps += p1[r];
  { auto rr = __builtin_amdgcn_permlane32_swap(__float_as_uint(ps), __float_as_uint(ps), false, false);
    ps = __uint_as_float(rr[0]) + __uint_as_float(rr[1]); }
  l_reg = l_reg * alpha + ps;
#define PK4(P, BASE, OUT) do { unsigned a0 = cvtpk(P[BASE + 0], P[BASE + 1]), a1 = cvtpk(P[BASE + 2], P[BASE + 3]);   \
    unsigned b0 = cvtpk(P[BASE + 4], P[BASE + 5]), b1 = cvtpk(P[BASE + 6], P[BASE + 7]);                              \
    auto r0 = __builtin_amdgcn_permlane32_swap(a0, b0, false, false); auto r1 = __builtin_amdgcn_permlane32_swap(a1, b1, false, false); \
    u32x4 w = {r0[0], r1[0], r0[1], r1[1]}; OUT = *reinterpret_cast<bf16x8*>(&w); } while (0)
  PK4(p0, 0, pa0); PK4(p0, 8, pa1); PK4(p1, 0, pa2); PK4(p1, 8, pa3);
#undef PK4
}
__device__ __forceinline__ void qkt(f32x16& p0, f32x16& p1, const bf16* Ks, const bf16x8* qr, int r32, int hi) {
  p0 = f32x16{}; p1 = f32x16{};
  for (int d0 = 0; d0 < 8; ++d0) { int cb = (d0 * 16 + hi * 8) * 2;
    bf16x8 b0 = *reinterpret_cast<const bf16x8*>((const char*)Ks + KSWZ(r32, cb));
    bf16x8 b1 = *reinterpret_cast<const bf16x8*>((const char*)Ks + KSWZ(32 + r32, cb));
    p0 = __builtin_amdgcn_mfma_f32_32x32x16_bf16(b0, qr[d0], p0, 0, 0, 0);
    p1 = __builtin_amdgcn_mfma_f32_32x32x16_bf16(b1, qr[d0], p1, 0, 0, 0); }
}
__device__ __forceinline__ int v_st(int k, int c) { const int kk = (k & ~0xC) | ((k & 4) << 1) | ((k & 8) >> 1); return ((kk >> 3) * 4 + (c >> 5)) * 512 + ((kk & 7) * 32 + (c & 31)) * 2; }
__device__ __forceinline__ int v_rd_base(int lane) { return ((lane & 3) << 3) | (((lane >> 2) & 3) << 6) | (((lane >> 4) & 1) << 5) | (((lane >> 5) & 1) << 8); }
constexpr int v_rd_off(int d0, int ks, int half) { return d0 * 512 + ks * 4096 + half * 2048; }
template <int OFF> __device__ __forceinline__ s16x4 tr_read(int vb) {
  s16x4 r; asm volatile("ds_read_b64_tr_b16 %0, %1 offset:%2" : "=&v"(r) : "v"(vb), "i"(OFF) : "memory"); return r;
}
template <int D0> __device__ __forceinline__ void pv_one(f32x16& od, int vb, bf16x8 pa0, bf16x8 pa1, bf16x8 pa2, bf16x8 pa3) {
  const s16x4 l0 = tr_read<v_rd_off(D0, 0, 0)>(vb), h0 = tr_read<v_rd_off(D0, 0, 1)>(vb), l1 = tr_read<v_rd_off(D0, 1, 0)>(vb), h1 = tr_read<v_rd_off(D0, 1, 1)>(vb);
  const s16x4 l2 = tr_read<v_rd_off(D0, 2, 0)>(vb), h2 = tr_read<v_rd_off(D0, 2, 1)>(vb), l3 = tr_read<v_rd_off(D0, 3, 0)>(vb), h3 = tr_read<v_rd_off(D0, 3, 1)>(vb);
  asm volatile("s_waitcnt lgkmcnt(0)" ::: "memory"); SBAR();
#define PK(L, H) (bf16x8){L[0], L[1], L[2], L[3], H[0], H[1], H[2], H[3]}
  od = __builtin_amdgcn_mfma_f32_32x32x16_bf16(pa0, PK(l0, h0), od, 0, 0, 0);
  od = __builtin_amdgcn_mfma_f32_32x32x16_bf16(pa1, PK(l1, h1), od, 0, 0, 0);
  od = __builtin_amdgcn_mfma_f32_32x32x16_bf16(pa2, PK(l2, h2), od, 0, 0, 0);
  od = __builtin_amdgcn_mfma_f32_32x32x16_bf16(pa3, PK(l3, h3), od, 0, 0, 0);
#undef PK
}
__device__ __forceinline__ void pv_d0(f32x16* o, int vb, bf16x8 pa0, bf16x8 pa1, bf16x8 pa2, bf16x8 pa3) {
  pv_one<0>(o[0], vb, pa0, pa1, pa2, pa3); pv_one<1>(o[1], vb, pa0, pa1, pa2, pa3); pv_one<2>(o[2], vb, pa0, pa1, pa2, pa3); pv_one<3>(o[3], vb, pa0, pa1, pa2, pa3);
}
struct NoHook { __device__ __forceinline__ void operator()(f32x16&, f32x16&, int, int, int, int) const {} };

template <int LDQ, int LDK, int LDO, int SDEPTH, class Hook>
__device__ __forceinline__ void attn_dense_body(const bf16* __restrict__ Qb, const bf16* __restrict__ Kh, const bf16* __restrict__ Vh,
                                                bf16* __restrict__ Ob, int seq, char* lds, const Hook& hook) {
  const int tid = opaque_tid(), wid = tid >> 6, lane = tid & 63, r32 = lane & 31, hi = lane >> 5;
  bf16* V_lds = (bf16*)lds; bf16* K_lds = (bf16*)(lds + 2 * SHM_V);
  float* ws = (float*)(lds + 2 * SHM_V + 2 * SHM_K) + wid * 64; float* li_l = ws; float* al_l = ws + 32;
  float m_reg = -1e30f, l_reg = 0; f32x16 o[4] = {}; bf16x8 qr[8];
  const bf16* Qw = Qb + (long)(wid * QBLK + r32) * LDQ + hi * 8;
#pragma unroll
  for (int d0 = 0; d0 < 8; ++d0) qr[d0] = ld8(Qw + d0 * 16);
  const int sr = tid >> 4, sc = (tid & 15) * 8, vst0 = v_st(sr, sc), vst1 = v_st(32 + sr, sc);
  const int vb0 = (int)(uintptr_t)V_lds + v_rd_base(lane);
  struct { bf16x8 vs0, vs1, ks0, ks1; } sr_[SDEPTH];
#define SLOAD(i, k0) do { sr_[i].vs0 = ld8(&Vh[(long)((k0) + sr) * LDK + sc]); sr_[i].vs1 = ld8(&Vh[(long)((k0) + 32 + sr) * LDK + sc]); \
    sr_[i].ks0 = ld8(&Kh[(long)((k0) + sr) * LDK + sc]); sr_[i].ks1 = ld8(&Kh[(long)((k0) + 32 + sr) * LDK + sc]); } while (0)
#define SWRITE(b, i) do { *(bf16x8*)((char*)V_lds + (b) * SHM_V + vst0) = sr_[i].vs0;          \
    *(bf16x8*)((char*)V_lds + (b) * SHM_V + vst1) = sr_[i].vs1; int kc = sc * 2;               \
    *(bf16x8*)((char*)K_lds + (b) * SHM_K + KSWZ(sr, kc)) = sr_[i].ks0;                       \
    *(bf16x8*)((char*)K_lds + (b) * SHM_K + KSWZ(32 + sr, kc)) = sr_[i].ks1; } while (0)
#define SWAIT() do { if constexpr (SDEPTH == 2) asm volatile("s_waitcnt vmcnt(4)" ::: "memory"); else asm volatile("s_waitcnt vmcnt(0)" ::: "memory"); } while (0)
#define RESC(a) do { if (__any((a) < 1.f)) { if (hi == 0) al_l[r32] = (a); asm volatile("s_waitcnt lgkmcnt(0)" ::: "memory"); \
    for (int d = 0; d < 4; ++d) for (int r = 0; r < 16; ++r) o[d][r] *= al_l[crow(r, hi)]; } } while (0)
  f32x16 pA0, pA1, pB0, pB1; float mnA, mnB, alA, alB; bf16x8 pa0, pa1, pa2, pa3; const int NT = seq / KVBLK;
  constexpr int SE = 0, SO = SDEPTH - 1;
  SLOAD(SE, 0); asm volatile("s_waitcnt vmcnt(0)" ::: "memory"); SWRITE(0, SE); __syncthreads();
  qkt(pA0, pA1, K_lds, qr, r32, hi); hook(pA0, pA1, 0, wid, r32, hi); partialSM(pA0, pA1, m_reg, mnA, alA);
  SLOAD(SO, KVBLK); if constexpr (SDEPTH == 2) { if (2 < NT) SLOAD(SE, 2 * KVBLK); }
  SWAIT(); SWRITE(1, SO); __syncthreads();
  for (int j = 1; j + 1 < NT; j += 2) {
    SBAR(); qkt(pB0, pB1, (bf16*)((char*)K_lds + SHM_K), qr, r32, hi);
    finishSM(pA0, pA1, alA, l_reg, pa0, pa1, pa2, pa3); SBAR();
    SLOAD(SO, (j + SDEPTH) * KVBLK); SBAR();
    pv_d0(o, vb0, pa0, pa1, pa2, pa3); hook(pB0, pB1, j, wid, r32, hi); partialSM(pB0, pB1, m_reg, mnB, alB);
    __syncthreads(); SWAIT(); SWRITE(0, SE);
    RESC(alB); __syncthreads();
    SBAR(); qkt(pA0, pA1, K_lds, qr, r32, hi);
    finishSM(pB0, pB1, alB, l_reg, pa0, pa1, pa2, pa3); SBAR();
    if (SDEPTH == 1 || j + 3 < NT) SLOAD(SE, (j + 1 + SDEPTH) * KVBLK); SBAR();
    pv_d0(o, vb0 + (int)SHM_V, pa0, pa1, pa2, pa3); hook(pA0, pA1, j + 1, wid, r32, hi); partialSM(pA0, pA1, m_reg, mnA, alA);
    __syncthreads(); SWAIT(); SWRITE(1, SO);
    RESC(alA); __syncthreads();
  }
  SBAR(); qkt(pB0, pB1, (bf16*)((char*)K_lds + SHM_K), qr, r32, hi);
  finishSM(pA0, pA1, alA, l_reg, pa0, pa1, pa2, pa3); SBAR();
  pv_d0(o, vb0, pa0, pa1, pa2, pa3); hook(pB0, pB1, NT - 1, wid, r32, hi); partialSM(pB0, pB1, m_reg, mnB, alB);
  __syncthreads(); RESC(alB);
  finishSM(pB0, pB1, alB, l_reg, pa0, pa1, pa2, pa3); SBAR();
  pv_d0(o, vb0 + (int)SHM_V, pa0, pa1, pa2, pa3);
  if (hi == 0) li_l[r32] = l_reg; asm volatile("s_waitcnt lgkmcnt(0)" ::: "memory");
  float rli[16];
#pragma unroll
  for (int r = 0; r < 16; ++r) rli[r] = __builtin_amdgcn_rcpf(li_l[crow(r, hi)]);
  bf16* Ow = Ob + (long)(wid * QBLK) * LDO;
#pragma unroll
  for (int r = 0; r < 16; ++r) { int orow = crow(r, hi);
#pragma unroll
    for (int d0 = 0; d0 < 4; ++d0) { const float v = o[d0][r] * rli[r]; const unsigned u = __float_as_uint(v); Ow[(long)orow * LDO + d0 * 32 + r32] = (bf16)((u + 0x7fffu + ((u >> 16) & 1u)) >> 16); } }
#undef SLOAD
#undef SWRITE
#undef SWAIT
#undef RESC
}
#undef KSWZ
#undef SBAR
}
constexpr int NWAVES = 8;
#ifndef ATT_SD
#define ATT_SD 2
#endif
#ifndef MK_PER_PHASE
#define MK_PER_PHASE 0
#endif

constexpr int S = 8192, DM = 4096, DFF = 11008, NL = 2;
constexpr int HD = 128, NHA = 16, NKVA = 4, NHB = 16, INC = 9216;
constexpr int C_QA = 0, C_KA = 2048, C_VA = 2560, C_QB = 3072, C_KB = 5120, C_VB = 7168;
constexpr int MEML = 256, NHM = 4, MEMW = 512;
constexpr float EPS = 1e-6f;
constexpr int NGU = 2 * DFF;
constexpr int PH_PER_LAYER = 16, NPH = 1 + PH_PER_LAYER * NL + 1;

constexpr size_t MiB = 1u << 20;
constexpr size_t WS_CTL = 0, CTL_ZERO_BYTES = 1 * MiB;
constexpr size_t SZ_GU = (size_t)NGU * DM * 2, SZ_D = (size_t)DM * DFF * 2, SZ_IN = (size_t)INC * DM * 2, SZ_OUT = (size_t)DM * DM * 2,
                 SZ_Q = (size_t)MEMW * DM * 2, SZ_KV = (size_t)2 * MEMW * DM * 2, SZ_O = (size_t)DM * MEMW * 2;
constexpr size_t LW_GU1 = 0, LW_D1 = LW_GU1 + SZ_GU, LW_IN = LW_D1 + SZ_D, LW_OUT = LW_IN + SZ_IN, LW_Q = LW_OUT + SZ_OUT, LW_KV = LW_Q + SZ_Q, LW_O = LW_KV + SZ_KV,
                 LW_GU2 = LW_O + SZ_O, LW_D2 = LW_GU2 + SZ_GU, LW_SIZE = LW_D2 + SZ_D;
constexpr size_t WS_W = 1 * MiB;
constexpr size_t WS_X = WS_W + NL * LW_SIZE;
constexpr size_t WS_H = WS_X + (size_t)S * DM * 4;
constexpr size_t WS_ACT = WS_H + (size_t)S * DM * 2;
constexpr size_t WS_PROJ = WS_ACT + (size_t)S * DFF * 2;
constexpr size_t WS_OB = WS_PROJ + (size_t)S * INC * 2;
constexpr size_t WS_XQ = WS_OB + (size_t)S * DM * 2;
constexpr size_t WS_XO = WS_XQ + (size_t)S * MEMW * 2;
constexpr size_t WS_MEMN = WS_XO + (size_t)S * MEMW * 2;
constexpr size_t WS_MKV = WS_MEMN + (size_t)MEML * DM * 2;
constexpr size_t WS_END = WS_MKV + (size_t)MEML * 2 * MEMW * 2;
static_assert(LW_SIZE % 256 == 0 && WS_X % 256 == 0 && WS_MKV % 256 == 0, "alignment");
constexpr int CW_BAR = 4096;

constexpr int RING_OFF = 0, RING_BYTES = 131072;
constexpr int TBL_OFF = 69632;
constexpr int LDSCTL_OFF = RING_BYTES, MISC_OFF = LDSCTL_OFF + 320;
constexpr int LDS_BYTES = 147456;
static_assert(att::SHM_ATTN <= TBL_OFF && TBL_OFF + 4096 <= RING_BYTES, "LDS map");

#define GAS __attribute__((address_space(1)))
#define LAS __attribute__((address_space(3)))
typedef unsigned short bf16;
typedef unsigned v4u __attribute__((ext_vector_type(4)));
typedef float f32x4 __attribute__((ext_vector_type(4)));
typedef short bf16x8 __attribute__((ext_vector_type(8)));
typedef GAS unsigned gu32;
typedef GAS unsigned long long gu64;
#define RLX_AGENT __ATOMIC_RELAXED, __HIP_MEMORY_SCOPE_AGENT
#define LDS_WAIT() asm volatile("s_waitcnt lgkmcnt(0)" ::: "memory")
#define VM_WAIT() asm volatile("s_waitcnt vmcnt(0)" ::: "memory")
__device__ __forceinline__ unsigned long long rt() { return __builtin_amdgcn_s_memrealtime(); }
__device__ __forceinline__ unsigned f2bf(float f) { unsigned u = __builtin_bit_cast(unsigned, f); return (u + 0x7fffu + ((u >> 16) & 1u)) >> 16; }
__device__ __forceinline__ unsigned pk2(float lo, float hi) { return f2bf(lo) | (f2bf(hi) << 16); }

#define XB_TMO      128
#define XB_XCNT(j)  (256  + 64 * (j))
#define XB_XSUB(j)  (1280 + 64 * (j))
#define XB_XGEN(j)  (2304 + 64 * (j))
#define XB_TOP      3328
#define XB_TOPGEN   3392
#define XCD_BAR_WORDS 3456
#define XB_SPIN_CAP (1u << 18)

__device__ __forceinline__ unsigned xb_ld(unsigned* p)              { return __hip_atomic_load(p, __ATOMIC_RELAXED, __HIP_MEMORY_SCOPE_AGENT); }
__device__ __forceinline__ unsigned xb_add(unsigned* p, unsigned v) { return __hip_atomic_fetch_add(p, v, __ATOMIC_RELAXED, __HIP_MEMORY_SCOPE_AGENT); }
__device__ __forceinline__ unsigned xb_xcc_id() { return (unsigned)__builtin_amdgcn_s_getreg((3 << 11) | 20) & 0xFu; }
#define XB_SPIN(cond, bar) do { unsigned _sp = 0; while (cond) { __builtin_amdgcn_s_sleep(1); \
    if ((++_sp & 255u) == 0u) { if (xb_ld(&(bar)[XB_TMO])) break; if (_sp > XB_SPIN_CAP) { atomicAdd(&(bar)[XB_TMO], 1u); break; } } } } while (0)

struct XcdBarrier {
    unsigned* bar; unsigned x;
    volatile LAS unsigned* st;
};

__device__ __forceinline__ XcdBarrier xcd_barrier_post(unsigned* bar, volatile LAS unsigned* st) {
    XcdBarrier b; b.bar = bar; b.x = xb_xcc_id(); b.st = st;
    if (threadIdx.x == 0) (void)xb_add(&bar[XB_XCNT(b.x)], 1u);
    return b;
}
__device__ __forceinline__ void xcd_barrier_complete(unsigned* bar, unsigned x, unsigned& nloc, unsigned& nx) {
    const unsigned G = gridDim.x * gridDim.y * gridDim.z;
    unsigned sum, cnt, mine, sp = 0u;
    for (;;) {
        sum = 0u; cnt = 0u; mine = 0u;
#pragma unroll
        for (unsigned j = 0; j < 16; ++j) { const unsigned c = xb_ld(&bar[XB_XCNT(j)]); sum += c; cnt += (c > 0u) ? 1u : 0u; mine = (j == x) ? c : mine; }
        if (sum == G) break;
        __builtin_amdgcn_s_sleep(1);
        if ((++sp & 255u) == 0u) { if (xb_ld(&bar[XB_TMO])) break; if (sp > XB_SPIN_CAP) { atomicAdd(&bar[XB_TMO], 1u); break; } }
    }
    nloc = mine > 0u ? mine : 1u; nx = cnt > 0u ? cnt : 1u;
}

__device__ __forceinline__ void xcd_barrier(const XcdBarrier& b) {
    asm volatile("s_waitcnt vmcnt(0)" ::: "memory");
    __syncthreads();
    if (threadIdx.x == 0) {
        unsigned* bar = b.bar;
        __builtin_amdgcn_s_waitcnt(0);
        unsigned nloc = b.st[0], nx = b.st[1];
        if (nloc == 0u) { xcd_barrier_complete(bar, b.x, nloc, nx); b.st[0] = nloc; b.st[1] = nx; }
        const unsigned old = xb_add(&bar[XB_XSUB(b.x)], 1u);
        const unsigned gen = old / nloc;
        if (old + 1u == (gen + 1u) * nloc) {
            __builtin_amdgcn_fence(__ATOMIC_RELEASE, "agent");
            asm volatile("s_waitcnt vmcnt(0)" ::: "memory");
            const unsigned og = xb_add(&bar[XB_TOP], 1u);
            const unsigned tg = og / nx;
            if (og + 1u == (tg + 1u) * nx) xb_add(&bar[XB_TOPGEN], 1u);
            else XB_SPIN(xb_ld(&bar[XB_TOPGEN]) == tg, bar);
            __builtin_amdgcn_fence(__ATOMIC_ACQUIRE, "agent");
            xb_add(&bar[XB_XGEN(b.x)], 1u);
            asm volatile("s_waitcnt vmcnt(0)" ::: "memory");
        } else {
            XB_SPIN(xb_ld(&bar[XB_XGEN(b.x)]) == gen, bar);
            __builtin_amdgcn_fence(__ATOMIC_ACQUIRE, "agent");
            asm volatile("s_waitcnt vmcnt(0)" ::: "memory");
        }
    }
    __syncthreads();
}

struct Frame {
    LAS unsigned char* lds;
    volatile LAS unsigned* MISC;
    gu32* ctl;
    int tid, lane, wave;
    int vcu, G;
};
__device__ __forceinline__ float wave_sum(float v) {
#pragma unroll
    for (int o = 1; o < 64; o <<= 1) v += __shfl_xor(v, o);
    return v;
}
__device__ __forceinline__ void transpose_item(const float* W, int K, int N, bf16* WT, int kb, int n0, int drow0, LAS float* scr, int lane) {
    const int k0 = 64 * kb;
#pragma unroll 8
    for (int i = 0; i < 32; ++i) { const int kk = 2 * i + (lane >> 5); scr[kk * 33 + (lane & 31)] = W[(size_t)(k0 + kk) * N + n0 + (lane & 31)]; }
    LDS_WAIT(); asm volatile("" ::: "memory");
    const int c = lane & 7;
#pragma unroll
    for (int j = 0; j < 4; ++j) { const int n = (lane >> 3) + 8 * j; const LAS float* s = scr + (8 * c) * 33 + n;
        v4u o; o.x = pk2(s[0 * 33], s[1 * 33]); o.y = pk2(s[2 * 33], s[3 * 33]); o.z = pk2(s[4 * 33], s[5 * 33]); o.w = pk2(s[6 * 33], s[7 * 33]);
        *(GAS v4u*)(WT + (size_t)(drow0 + n) * K + k0 + 8 * c) = o; }
    LDS_WAIT(); asm volatile("" ::: "memory");
}
constexpr int I_G = (DM / 64) * (DFF / 32), I_D = (DFF / 64) * (DM / 32), I_IN = (DM / 64) * (INC / 32), I_OUT = (DM / 64) * (DM / 32),
              I_Q = (DM / 64) * (MEMW / 32), I_KV = (DM / 64) * (2 * MEMW / 32), I_O = (MEMW / 64) * (DM / 32);
constexpr int ITEMS_LAYER = 6 * I_G + I_IN + I_OUT + I_Q + I_KV + I_O;
static_assert(I_G == I_D, "gate/up/down item counts");

struct Args { const float* in[24]; float* out; unsigned char* ws; int ph_lo, ph_hi; };

__device__ __forceinline__ void p0_prologue(Frame& F, const Args& args) {
    const int tid_ = opaque_tid(), lane_ = tid_ & 63, wave_ = __builtin_amdgcn_readfirstlane(tid_ >> 6); (void)tid_; (void)lane_; (void)wave_;
    LAS float* scr = (LAS float*)(F.lds + RING_OFF + wave_ * 16384);
    const int gw = F.vcu * NWAVES + wave_, NGW = F.G * NWAVES;
    for (int it = gw; it < NL * ITEMS_LAYER; it += NGW) {
        const int l = it / ITEMS_LAYER; int r = it - l * ITEMS_LAYER;
        unsigned char* wl = args.ws + WS_W + (size_t)l * LW_SIZE;
        const float* W; int K, N; bf16* WT; int mode = 0;
        if (r < I_G) { W = args.in[3] + (size_t)l * DM * DFF; K = DM; N = DFF; WT = (bf16*)(wl + LW_GU1); mode = 1; }
        else if ((r -= I_G) < I_G) { W = args.in[4] + (size_t)l * DM * DFF; K = DM; N = DFF; WT = (bf16*)(wl + LW_GU1); mode = 2; }
        else if ((r -= I_G) < I_D) { W = args.in[5] + (size_t)l * DFF * DM; K = DFF; N = DM; WT = (bf16*)(wl + LW_D1); }
        else if ((r -= I_D) < I_IN) { W = args.in[7] + (size_t)l * DM * INC; K = DM; N = INC; WT = (bf16*)(wl + LW_IN); }
        else if ((r -= I_IN) < I_OUT) { W = args.in[13] + (size_t)l * DM * DM; K = DM; N = DM; WT = (bf16*)(wl + LW_OUT); }
        else if ((r -= I_OUT) < I_Q) { W = args.in[16] + (size_t)l * DM * MEMW; K = DM; N = MEMW; WT = (bf16*)(wl + LW_Q); }
        else if ((r -= I_Q) < I_KV) { W = args.in[17] + (size_t)l * DM * 2 * MEMW; K = DM; N = 2 * MEMW; WT = (bf16*)(wl + LW_KV); }
        else if ((r -= I_KV) < I_O) { W = args.in[18] + (size_t)l * MEMW * DM; K = MEMW; N = DM; WT = (bf16*)(wl + LW_O); }
        else if ((r -= I_O) < I_G) { W = args.in[20] + (size_t)l * DM * DFF; K = DM; N = DFF; WT = (bf16*)(wl + LW_GU2); mode = 1; }
        else if ((r -= I_G) < I_G) { W = args.in[21] + (size_t)l * DM * DFF; K = DM; N = DFF; WT = (bf16*)(wl + LW_GU2); mode = 2; }
        else { r -= I_G; W = args.in[22] + (size_t)l * DFF * DM; K = DFF; N = DM; WT = (bf16*)(wl + LW_D2); }
        const int nblk = N / 32, kb = r / nblk, n0 = 32 * (r % nblk);
        const int drow0 = mode == 0 ? n0 : (256 * (n0 >> 7) + (n0 & 127) + (mode == 2 ? 128 : 0));
        transpose_item(W, K, N, WT, kb, n0, drow0, scr, lane_);
    }
}
__device__ __forceinline__ void rms_rows_bf16(Frame& F, const float* X, const float* g, bf16* H, int nrows) {
    const int tid_ = opaque_tid(), lane_ = tid_ & 63, wave_ = __builtin_amdgcn_readfirstlane(tid_ >> 6); (void)tid_; (void)lane_; (void)wave_;
    const int gw = F.vcu * NWAVES + wave_, NGW = F.G * NWAVES;
    f32x4 gv[16];
#pragma unroll
    for (int j = 0; j < 16; ++j) gv[j] = ((const GAS f32x4*)g)[64 * j + lane_];
    for (int m = gw; m < nrows; m += NGW) {
        const GAS f32x4* xr = (const GAS f32x4*)(X + (size_t)m * DM) + lane_;
        f32x4 v[16]; float s = 0.f;
#pragma unroll
        for (int j = 0; j < 16; ++j) { v[j] = xr[64 * j]; s += (v[j].x * v[j].x + v[j].y * v[j].y) + (v[j].z * v[j].z + v[j].w * v[j].w); }
        const float rstd = 1.f / sqrtf(wave_sum(s) * (1.f / DM) + EPS);
        GAS unsigned long long* o8 = (GAS unsigned long long*)(H + (size_t)m * DM) + lane_;
#pragma unroll
        for (int j = 0; j < 16; ++j) { const f32x4 y = v[j] * rstd * gv[j]; o8[64 * j] = (unsigned long long)pk2(y.x, y.y) | ((unsigned long long)pk2(y.z, y.w) << 32); }
    }
}
__device__ __forceinline__ void rms_rows_f32(Frame& F, const float* X, const float* g, float* O, int nrows, bool poison) {
    const int tid_ = opaque_tid(), lane_ = tid_ & 63, wave_ = __builtin_amdgcn_readfirstlane(tid_ >> 6); (void)tid_; (void)lane_; (void)wave_;
    const int gw = F.vcu * NWAVES + wave_, NGW = F.G * NWAVES;
    f32x4 gv[16];
#pragma unroll
    for (int j = 0; j < 16; ++j) gv[j] = ((const GAS f32x4*)g)[64 * j + lane_];
    for (int m = gw; m < nrows; m += NGW) {
        const GAS f32x4* xr = (const GAS f32x4*)(X + (size_t)m * DM) + lane_;
        f32x4 v[16]; float s = 0.f;
#pragma unroll
        for (int j = 0; j < 16; ++j) { v[j] = xr[64 * j]; s += (v[j].x * v[j].x + v[j].y * v[j].y) + (v[j].z * v[j].z + v[j].w * v[j].w); }
        float rstd = 1.f / sqrtf(wave_sum(s) * (1.f / DM) + EPS);
        if (poison) rstd = __builtin_nanf("");
        GAS f32x4* o = (GAS f32x4*)(O + (size_t)m * DM) + lane_;
#pragma unroll
        for (int j = 0; j < 16; ++j) o[64 * j] = v[j] * rstd * gv[j];
    }
}
__device__ __forceinline__ void outnorm_rows(Frame& F, bf16* O, const float* ga, const float* gb) {
    const int tid_ = opaque_tid(), lane_ = tid_ & 63, wave_ = __builtin_amdgcn_readfirstlane(tid_ >> 6); (void)tid_; (void)lane_; (void)wave_;
    const int gw = F.vcu * NWAVES + wave_, NGW = F.G * NWAVES;
    f32x4 gv[8][2];
#pragma unroll
    for (int j = 0; j < 8; ++j) { const float* g = (j < 4 ? ga + 512 * j : gb + 512 * (j - 4)) + 8 * lane_; gv[j][0] = *(const GAS f32x4*)g; gv[j][1] = *(const GAS f32x4*)(g + 4); }
    for (int m = gw; m < S; m += NGW) {
        GAS v4u* p = (GAS v4u*)(O + (size_t)m * DM) + lane_;
        v4u w[8]; float sa = 0.f, sb = 0.f;
#pragma unroll
        for (int j = 0; j < 8; ++j) { w[j] = p[64 * j]; float s = 0.f;
#pragma unroll
            for (int e = 0; e < 4; ++e) { const float lo = __uint_as_float(w[j][e] << 16), hi = __uint_as_float(w[j][e] & 0xffff0000u); s += lo * lo + hi * hi; }
            if (j < 4) sa += s; else sb += s; }
        const float ra = 1.f / sqrtf(wave_sum(sa) * (1.f / 2048.f) + EPS), rb = 1.f / sqrtf(wave_sum(sb) * (1.f / 2048.f) + EPS);
#pragma unroll
        for (int j = 0; j < 8; ++j) { const float r = j < 4 ? ra : rb; v4u o;
#pragma unroll
            for (int e = 0; e < 4; ++e) { const float lo = __uint_as_float(w[j][e] << 16), hi = __uint_as_float(w[j][e] & 0xffff0000u);
                const float g0 = e < 2 ? gv[j][0][2 * e] : gv[j][1][2 * e - 4], g1 = e < 2 ? gv[j][0][2 * e + 1] : gv[j][1][2 * e - 3];
                o[e] = pk2(lo * r * g0, hi * r * g1); }
            p[64 * j] = o; }
    }
}
__device__ __forceinline__ void qk_prep(Frame& F, bf16* PROJ, const float* qg, const float* kg) {
    const int tid_ = opaque_tid(), lane_ = tid_ & 63, wave_ = __builtin_amdgcn_readfirstlane(tid_ >> 6); (void)tid_; (void)lane_; (void)wave_;
    LAS float* tab = (LAS float*)(F.lds + RING_OFF);
    for (int idx = tid_; idx < 128 * 32; idx += NWAVES * 64) { const int pos = idx >> 5, f = idx & 31;
        const float invf = powf(10000.f, -(float)f * (1.f / 32.f)); float sn, cs; sincosf((float)pos * invf, &sn, &cs); tab[idx] = cs; tab[4096 + idx] = sn; }
    __syncthreads();
    const int gw = F.vcu * NWAVES + wave_, NGW = F.G * NWAVES;
    const int hsub = lane_ >> 4, axis = (lane_ >> 3) & 1, jp = lane_ & 7, eo = axis * 64 + 4 * jp;
    const f32x4 q1 = *(const GAS f32x4*)(qg + eo), q2 = *(const GAS f32x4*)(qg + eo + 32), k1 = *(const GAS f32x4*)(kg + eo), k2 = *(const GAS f32x4*)(kg + eo + 32);
    for (int it = gw; it < S * 5; it += NGW) {
        const int t = it / 5, grp = it - 5 * t, hh = grp * 4 + hsub;
        GAS unsigned long long* p = (GAS unsigned long long*)(PROJ + (size_t)t * INC + hh * HD + eo);
        const unsigned long long w1 = p[0], w2 = p[8];
        float x1[4], x2[4];
        x1[0] = __uint_as_float((unsigned)w1 << 16); x1[1] = __uint_as_float((unsigned)w1 & 0xffff0000u); x1[2] = __uint_as_float((unsigned)(w1 >> 32) << 16); x1[3] = __uint_as_float((unsigned)(w1 >> 32) & 0xffff0000u);
        x2[0] = __uint_as_float((unsigned)w2 << 16); x2[1] = __uint_as_float((unsigned)w2 & 0xffff0000u); x2[2] = __uint_as_float((unsigned)(w2 >> 32) << 16); x2[3] = __uint_as_float((unsigned)(w2 >> 32) & 0xffff0000u);
        float ss = 0.f;
#pragma unroll
        for (int e = 0; e < 4; ++e) ss += x1[e] * x1[e] + x2[e] * x2[e];
        ss += __shfl_xor(ss, 1); ss += __shfl_xor(ss, 2); ss += __shfl_xor(ss, 4); ss += __shfl_xor(ss, 8);
        const float rstd = 1.f / sqrtf(ss * (1.f / HD) + EPS);
        const f32x4 g1 = grp < 4 ? q1 : k1, g2 = grp < 4 ? q2 : k2;
        const int pos = axis ? (t & 63) : (t >> 6);
        const LAS float* tc = tab + pos * 32 + 4 * jp;
        float o1[4], o2[4];
#pragma unroll
        for (int e = 0; e < 4; ++e) { const float y1 = x1[e] * rstd * g1[e], y2 = x2[e] * rstd * g2[e], c = tc[e], s = tc[4096 + e]; o1[e] = y1 * c - y2 * s; o2[e] = y2 * c + y1 * s; }
        p[0] = (unsigned long long)pk2(o1[0], o1[1]) | ((unsigned long long)pk2(o1[2], o1[3]) << 32);
        p[8] = (unsigned long long)pk2(o2[0], o2[1]) | ((unsigned long long)pk2(o2[2], o2[3]) << 32);
    }
}
struct NattenHook {
    const LAS float* tbl; int i0, kr0;
    __device__ __forceinline__ void operator()(att::f32x16& p0, att::f32x16& p1, int tile, int wid, int r32, int hi) const {
        const int i = i0 + (wid >> 1), cq = (wid & 1) * 32 + r32;
        const int rs = min(max(i - 4, 0), 120), cs = min(max(cq - 8, 0), 48), kr = kr0 + tile;
        const float NEG = -__builtin_inff();
        if ((unsigned)(kr - rs) >= 8u) {
#pragma unroll
            for (int r = 0; r < 16; ++r) { p0[r] = NEG; p1[r] = NEG; }
            return; }
        const LAS float* tp = tbl + ((kr - i + 7) * 31 + 15 - cq + 4 * hi);
        const int d0 = 4 * hi - cs;
#pragma unroll
        for (int r = 0; r < 16; ++r) { const int kcc = (r & 3) + 8 * (r >> 2);
            const float b = tp[kcc], b2 = tp[kcc + 32];
            p0[r] = ((unsigned)(kcc + d0) < 16u) ? p0[r] + b : NEG; p1[r] = ((unsigned)(kcc + 32 + d0) < 16u) ? p1[r] + b2 : NEG;
            if ((r & 3) == 3) __builtin_amdgcn_sched_barrier(0); }
    }
};

__global__ void __launch_bounds__(NWAVES * 64, 2) mega_fwd(Args args) {
    extern __shared__ __attribute__((aligned(16))) unsigned char lds[];
    Frame F;
    F.lds = (LAS unsigned char*)lds;
    F.MISC = (volatile LAS unsigned*)(F.lds + MISC_OFF);
    F.tid = threadIdx.x; F.lane = F.tid & 63; F.wave = __builtin_amdgcn_readfirstlane(F.tid >> 6);
    F.G = gridDim.x; { const int bx = blockIdx.x; F.vcu = (F.G % 8 == 0) ? (bx % 8) * (F.G / 8) + bx / 8 : bx; }
    unsigned char* ws = args.ws;
    F.ctl = (gu32*)(ws + WS_CTL);
    for (int u = F.tid; u < (LDS_BYTES - LDSCTL_OFF) / 4; u += NWAVES * 64) ((LAS unsigned*)(F.lds + LDSCTL_OFF))[u] = 0u;
    __syncthreads();
    XcdBarrier bar; bar.bar = (unsigned*)(F.ctl + CW_BAR); bar.x = 0; bar.st = nullptr;
    if (!MK_PER_PHASE) bar = xcd_barrier_post((unsigned*)(F.ctl + CW_BAR), F.MISC + 8);
#define GRID_BAR() do { if (MK_PER_PHASE) { if (F.tid == 0) __hip_atomic_store(F.ctl + 0, 0xBADBA0u, RLX_AGENT); } else { xcd_barrier(bar); } } while (0)
    const int lo = args.ph_lo, hi = args.ph_hi;
#ifndef PHMASK
#define PHMASK 0xffffffffu
#endif
#define IN(k) (lo <= (k) && (k) < hi)
#define EN(j) ((PHMASK >> (j)) & 1u)
#define SEAM(k) do { if (IN(k) && IN((k) + 1)) GRID_BAR(); } while (0)

    float* X = (float*)(ws + WS_X); bf16* H = (bf16*)(ws + WS_H); bf16* ACT = (bf16*)(ws + WS_ACT); bf16* PROJ = (bf16*)(ws + WS_PROJ); bf16* OB = (bf16*)(ws + WS_OB);
    bf16* XQ = (bf16*)(ws + WS_XQ); bf16* XO = (bf16*)(ws + WS_XO); bf16* MEMN = (bf16*)(ws + WS_MEMN); bf16* MKV = (bf16*)(ws + WS_MKV);

    if (IN(0)) { p0_prologue(F, args); }
    SEAM(0);

    for (int l = 0; l < NL; ++l) {
        const int pb = 1 + PH_PER_LAYER * l;
        unsigned char* wl = ws + WS_W + (size_t)l * LW_SIZE;
        const float* xin = (l == 0) ? args.in[0] : X;

        if (EN(0) && IN(pb + 0)) rms_rows_bf16(F, xin, args.in[2] + (size_t)l * DM, H, S);
        SEAM(pb + 0);
        if (EN(1) && IN(pb + 1)) { pg8::Gemm g{H, (const bf16*)(wl + LW_GU1), S, NGU, DM}; pg8::StaticOrder So; So.init(S, NGU, F.G, (int)blockIdx.x);
            pg8::EpiSwiglu E{ACT, DFF}; pg8::gemm_phase<pg8::EpiSwiglu, pg8::StaticOrder, true, true>(F.lds + RING_OFF, g, So, E); }
        SEAM(pb + 1);
        if (EN(2) && IN(pb + 2)) { pg8::Gemm g{ACT, (const bf16*)(wl + LW_D1), S, DM, DFF}; pg8::StaticOrder So; So.init(S, DM, F.G, (int)blockIdx.x);
            pg8::EpiResid E{xin, X, DM, 0.5f}; pg8::gemm_phase<pg8::EpiResid, pg8::StaticOrder, true, true>(F.lds + RING_OFF, g, So, E); }
        SEAM(pb + 2);
        if (EN(3) && IN(pb + 3)) rms_rows_bf16(F, X, args.in[6] + (size_t)l * DM, H, S);
        SEAM(pb + 3);
        if (EN(4) && IN(pb + 4)) { pg8::Gemm g{H, (const bf16*)(wl + LW_IN), S, INC, DM}; pg8::StaticOrder So; So.init(S, INC, F.G, (int)blockIdx.x);
            pg8::EpiBf16 E{PROJ, INC}; pg8::gemm_phase<pg8::EpiBf16, pg8::StaticOrder, true, true>(F.lds + RING_OFF, g, So, E); }
        SEAM(pb + 4);
        if (EN(5) && IN(pb + 5)) { qk_prep(F, PROJ, args.in[8] + (size_t)l * HD, args.in[9] + (size_t)l * HD); __syncthreads(); }
        SEAM(pb + 5);
        if (EN(6) && IN(pb + 6)) {
#ifndef NO_GLOBAL
            for (int u = F.vcu; u < NHA * (S / 256); u += F.G) { const int h = u >> 5, qb = u & 31, kvh = h >> 2;
                att::attn_dense_body<INC, INC, DM, ATT_SD, att::NoHook>(PROJ + (size_t)qb * 256 * INC + C_QA + h * HD, PROJ + C_KA + kvh * HD, PROJ + C_VA + kvh * HD,
                                                                OB + (size_t)qb * 256 * DM + h * HD, S, (char*)lds + RING_OFF, att::NoHook{});
                __syncthreads(); }
#endif
#ifndef NO_NATTEN
            for (int u = F.vcu; u < NHB * (S / 256); u += F.G) { const int h = u >> 5, blk = u & 31, i0 = 4 * blk, kr0 = min(max(i0 - 4, 0), 116);
                LAS float* tbl = (LAS float*)(F.lds + TBL_OFF + 256); const float* rp = args.in[10] + ((size_t)l * NHB + h) * 15 * 31;
                for (int i = opaque_tid(); i < 15 * 31; i += NWAVES * 64) tbl[i] = rp[i] * (1.0f / att::SCALE);
                __syncthreads();
                NattenHook hk{tbl, i0, kr0};
                att::attn_dense_body<INC, INC, DM, 1, NattenHook>(PROJ + (size_t)blk * 256 * INC + C_QB + h * HD, PROJ + (size_t)kr0 * 64 * INC + C_KB + h * HD, PROJ + (size_t)kr0 * 64 * INC + C_VB + h * HD,
                                                               OB + (size_t)blk * 256 * DM + 2048 + h * HD, 768, (char*)lds + RING_OFF, hk);
                __syncthreads(); }
#endif
        }
        SEAM(pb + 6);
        if (EN(7) && IN(pb + 7)) outnorm_rows(F, OB, args.in[11] + (size_t)l * 2048, args.in[12] + (size_t)l * 2048);
        SEAM(pb + 7);
        if (EN(8) && IN(pb + 8)) { pg8::Gemm g{OB, (const bf16*)(wl + LW_OUT), S, DM, DM}; pg8::StaticOrder So; So.init(S, DM, F.G, (int)blockIdx.x);
            pg8::EpiResid E{X, X, DM, 1.0f}; pg8::gemm_phase<pg8::EpiResid, pg8::StaticOrder, true, true>(F.lds + RING_OFF, g, So, E); }
        SEAM(pb + 8);
        if (EN(9) && IN(pb + 9)) { rms_rows_bf16(F, X, args.in[14] + (size_t)l * DM, H, S); rms_rows_bf16(F, args.in[1], args.in[15] + (size_t)l * DM, MEMN, MEML); }
        SEAM(pb + 9);
        if (EN(10) && IN(pb + 10)) {
            { pg8::Gemm g{H, (const bf16*)(wl + LW_Q), S, MEMW, DM}; pg8::StaticOrder So; So.init(S, MEMW, F.G, (int)blockIdx.x);
              pg8::EpiBf16 E{XQ, MEMW}; pg8::gemm_phase<pg8::EpiBf16, pg8::StaticOrder, true, true>(F.lds + RING_OFF, g, So, E); }
            { pg8::Gemm g{MEMN, (const bf16*)(wl + LW_KV), MEML, 2 * MEMW, DM}; pg8::StaticOrder So; So.init(MEML, 2 * MEMW, F.G, (int)((blockIdx.x + F.G / 2) % F.G));
              pg8::EpiBf16 E{MKV, 2 * MEMW}; pg8::gemm_phase<pg8::EpiBf16, pg8::StaticOrder, true, true>(F.lds + RING_OFF, g, So, E); }
        }
        SEAM(pb + 10);
        if (EN(11) && IN(pb + 11)) {
            for (int u = F.vcu; u < NHM * (S / 256); u += F.G) { const int h = u >> 5, qb = u & 31;
                att::attn_dense_body<MEMW, 2 * MEMW, MEMW, 1, att::NoHook>(XQ + (size_t)qb * 256 * MEMW + h * HD, MKV + h * HD, MKV + MEMW + h * HD,
                                                                        XO + (size_t)qb * 256 * MEMW + h * HD, MEML, (char*)lds + RING_OFF, att::NoHook{});
                __syncthreads(); }
        }
        SEAM(pb + 11);
        if (EN(12) && IN(pb + 12)) { pg8::Gemm g{XO, (const bf16*)(wl + LW_O), S, DM, MEMW}; pg8::StaticOrder So; So.init(S, DM, F.G, (int)blockIdx.x);
            pg8::EpiResid E{X, X, DM, 1.0f}; pg8::gemm_phase<pg8::EpiResid, pg8::StaticOrder, true, true>(F.lds + RING_OFF, g, So, E); }
        SEAM(pb + 12);
        if (EN(13) && IN(pb + 13)) rms_rows_bf16(F, X, args.in[19] + (size_t)l * DM, H, S);
        SEAM(pb + 13);
        if (EN(14) && IN(pb + 14)) { pg8::Gemm g{H, (const bf16*)(wl + LW_GU2), S, NGU, DM}; pg8::StaticOrder So; So.init(S, NGU, F.G, (int)blockIdx.x);
            pg8::EpiSwiglu E{ACT, DFF}; pg8::gemm_phase<pg8::EpiSwiglu, pg8::StaticOrder, true, true>(F.lds + RING_OFF, g, So, E); }
        SEAM(pb + 14);
        if (EN(15) && IN(pb + 15)) { pg8::Gemm g{ACT, (const bf16*)(wl + LW_D2), S, DM, DFF}; pg8::StaticOrder So; So.init(S, DM, F.G, (int)blockIdx.x);
            pg8::EpiResid E{X, X, DM, 0.5f}; pg8::gemm_phase<pg8::EpiResid, pg8::StaticOrder, true, true>(F.lds + RING_OFF, g, So, E); }
        SEAM(pb + 15);
    }
    if (IN(NPH - 1)) {
        bool poison = false;
        if (!MK_PER_PHASE) poison = __hip_atomic_load((gu32*)((unsigned*)(F.ctl + CW_BAR) + XB_TMO), RLX_AGENT) != 0u;
        rms_rows_f32(F, X, args.in[23], args.out, S, poison);
    }
#undef IN
#undef SEAM
#undef GRID_BAR
}

extern "C" void kernel_launch(void* const* d_in, const int* in_sizes, int n_in, void* d_out, int out_size, void* d_ws, size_t ws_size, hipStream_t stream) {
    static int grid = 0;
    if (grid == 0) {
        if (n_in != 24 || in_sizes[0] != S * DM || out_size != S * DM || ws_size < WS_END) { fprintf(stderr, "kernel_launch: shape mismatch: n_in %d in0 %d out %d ws %zu (need %zu)\n", n_in, n_in > 0 ? in_sizes[0] : -1, out_size, ws_size, (size_t)WS_END); grid = -1; return; }
        int dev = 0, cus = 0, per_cu = 0;
        if (hipGetDevice(&dev) != hipSuccess || hipDeviceGetAttribute(&cus, hipDeviceAttributeMultiprocessorCount, dev) != hipSuccess) { grid = -1; return; }
        if (hipFuncSetAttribute((const void*)mega_fwd, hipFuncAttributeMaxDynamicSharedMemorySize, LDS_BYTES) != hipSuccess) { fprintf(stderr, "kernel_launch: hipFuncSetAttribute failed\n"); grid = -1; return; }
        if (hipOccupancyMaxActiveBlocksPerMultiprocessor(&per_cu, (const void*)mega_fwd, NWAVES * 64, LDS_BYTES) != hipSuccess || per_cu < 1)
            fprintf(stderr, "kernel_launch: note: occupancy query reports %d workgroups per CU\n", per_cu);
        (void)hipGetLastError();
        grid = cus;
    }
    if (grid < 0) return;
    if (hipMemsetAsync((char*)d_ws + WS_CTL, 0, CTL_ZERO_BYTES, stream) != hipSuccess) { fprintf(stderr, "kernel_launch: memset failed\n"); return; }
    Args a{};
    for (int i = 0; i < 24; ++i) a.in[i] = (const float*)d_in[i];
    a.out = (float*)d_out; a.ws = (unsigned char*)d_ws;
#if MK_PER_PHASE
    for (int p = 0; p < NPH; ++p) { a.ph_lo = p; a.ph_hi = p + 1; hipLaunchKernelGGL(mega_fwd, dim3(grid), dim3(NWAVES * 64), LDS_BYTES, stream, a); }
#else
    a.ph_lo = 0; a.ph_hi = NPH; hipLaunchKernelGGL(mega_fwd, dim3(grid), dim3(NWAVES * 64), LDS_BYTES, stream, a);
#endif
    const hipError_t le = hipPeekAtLastError();
    if (le != hipSuccess) fprintf(stderr, "kernel_launch: launch failed: %s\n", hipGetErrorName(le));
}
```

```cpp
#include <hip/hip_runtime.h>
#include <cstdio>
#include <cstdint>
__device__ __forceinline__ int opaque_tid() { int t = (int)threadIdx.x; asm volatile("" : "+v"(t)); return t; }
__device__ __forceinline__ int opaque_bid() { int b = (int)blockIdx.x; asm volatile("" : "+s"(b)); return b; }
__device__ __forceinline__ float opqf(float x) { asm volatile("" : "+v"(x)); return x; }
namespace pg8 {
#define PG8_LAS __attribute__((address_space(3)))
typedef unsigned short bf16_t;
typedef short bf16x8 __attribute__((ext_vector_type(8)));
typedef float f32x4 __attribute__((ext_vector_type(4)));
typedef unsigned u32x4 __attribute__((ext_vector_type(4)));
constexpr int BM = 256, BK = 64, HALF = 128, HTB = HALF * BK * 2  , STAGE_BYTES = 8 * HTB, NXCD = 8, WGM = 4;

__host__ __device__ __forceinline__ int lds_byte(int r, int c) { const int st = (r >> 4) * 2 + (c >> 5), rr = r & 15, cc = c & 31, ob = rr * 64 + cc * 2; return st * 1024 + (ob ^ (((ob >> 9) & 1) << 5)); }
__host__ __device__ __forceinline__ void stage_rc(int b, int& R, int& C) { const int st = b / 1024, sb = b % 1024, swz = sb ^ (((sb >> 9) & 1) << 5); R = (st >> 1) * 16 + swz / 64; C = (st & 1) * 32 + (swz % 64) / 2; }
__host__ __device__ __forceinline__ int perm32(int rho) { const int n = rho >> 4, i = rho & 15; return 8 * (i >> 2) + 4 * n + (i & 3); }

struct Unit { int pm, pn, ks, kofs; };
struct Gemm { const bf16_t* A; const bf16_t* Bt; int M, N, K, ld; };

struct StaticOrder {
    int nM, nN, nwg, G, c;
    __host__ __device__ void init(int M, int N, int G_, int c_) { nM = M / BM; nN = N / BM; nwg = nM * nN; G = G_; c = c_; }
    __host__ __device__ bool next(int i, Unit& u) const {
        const long L = (long)i * G + c; if (L >= nwg) return false;
        int wgid = (int)L; { const int q = nwg / NXCD, r = nwg % NXCD, xcd = wgid % NXCD, off = wgid / NXCD; wgid = (xcd < r ? xcd * (q + 1) : r * (q + 1) + (xcd - r) * q) + off; }
        const int nig = WGM * nN, gid = wgid / nig, fm = gid * WGM, gsz = (nM - fm) < WGM ? (nM - fm) : WGM;
        u.pm = fm + ((wgid % nig) % gsz); u.pn = (wgid % nig) / gsz; u.ks = 0; u.kofs = 0; return true;
    }
    __device__ __forceinline__ void a_ready(const Unit&) const {}
    __device__ __forceinline__ void done(const Unit&) const {}
};
__device__ __forceinline__ unsigned cvt_pk_bf16(float lo, float hi) { unsigned r; asm volatile("v_cvt_pk_bf16_f32 %0, %1, %2" : "=v"(r) : "v"(lo), "v"(hi)); return r; }
typedef float f32x2 __attribute__((ext_vector_type(2)));
constexpr float SS_FIX = 1048576.0f;
__device__ __forceinline__ float rstd_of(const unsigned long long* ss, int row) { const float s = (float)ss[row] * (1.0f / SS_FIX); return 1.0f / sqrtf(s * (1.0f / 4096.0f) + 1e-6f); }
struct EpiBf16 {
    static constexpr bool PERM = true, AFTER_DRAIN = false, MIDSCALE = false;
    bf16_t* O; int ldc; const unsigned long long* ss; const PG8_LAS float* rs; int rs_pm;
    __device__ __forceinline__ void operator()(const f32x4 (&acc)[2][2][4][2], const Unit& u, int wr, int wc, int fr, int fq) const {
        const int row0 = u.pm * BM + wr * 64 + fr, col0 = u.pn * BM + wc * 32 + 8 * fq;
        float rsv[8];
        if (!ss) {
#pragma unroll
            for (int k = 0; k < 8; ++k) rsv[k] = 1.0f;
        } else if (u.pm == rs_pm) {
#pragma unroll
            for (int k = 0; k < 8; ++k) rsv[k] = rs[wr * 64 + fr + (k >> 2) * HALF + (k & 3) * 16];
        } else {
#pragma unroll
            for (int k = 0; k < 8; ++k) rsv[k] = rstd_of(ss, row0 + (k >> 2) * HALF + (k & 3) * 16);
        }
#pragma unroll
        for (int ai = 0; ai < 2; ++ai)
#pragma unroll
            for (int m = 0; m < 4; ++m) { const int row = row0 + ai * HALF + m * 16; bf16_t* rowp = O + (size_t)row * ldc + col0; const float rs_ = rsv[ai * 4 + m];
#pragma unroll
                for (int bj = 0; bj < 2; ++bj) { const f32x4 v0 = acc[ai][bj][m][0] * rs_, v1 = acc[ai][bj][m][1] * rs_;
                    u32x4 w; w.x = cvt_pk_bf16(v0[0], v0[1]); w.y = cvt_pk_bf16(v0[2], v0[3]); w.z = cvt_pk_bf16(v1[0], v1[1]); w.w = cvt_pk_bf16(v1[2], v1[3]);
                    *(u32x4*)(rowp + bj * HALF) = w; } }
    }
};
__device__ __forceinline__ float silu_mul(float g, float u) { const float e = __builtin_amdgcn_exp2f(g * -1.4426950408889634f); return g * __builtin_amdgcn_rcpf(1.0f + e) * u; }
struct EpiSwiglu {
    static constexpr bool PERM = true, AFTER_DRAIN = false, MIDSCALE = false;
    bf16_t* O; int ldc; const unsigned long long* ss; const PG8_LAS float* rs; int rs_pm;
    __device__ __forceinline__ void operator()(const f32x4 (&acc)[2][2][4][2], const Unit& u, int wr, int wc, int fr, int fq) const {
        const int row0 = u.pm * BM + wr * 64 + fr, col0 = u.pn * HALF + wc * 32 + 8 * fq;
        float rsv[8];
        if (u.pm == rs_pm) {
#pragma unroll
            for (int k = 0; k < 8; ++k) rsv[k] = rs[wr * 64 + fr + (k >> 2) * HALF + (k & 3) * 16];
        } else {
#pragma unroll
            for (int k = 0; k < 8; ++k) rsv[k] = rstd_of(ss, row0 + (k >> 2) * HALF + (k & 3) * 16);
        }
#pragma unroll
        for (int ai = 0; ai < 2; ++ai)
#pragma unroll
            for (int m = 0; m < 4; ++m) { const int row = row0 + ai * HALF + m * 16; bf16_t* rowp = O + (size_t)row * ldc + col0; const float rs_ = rsv[ai * 4 + m];
                const f32x4 ag0 = acc[ai][0][m][0], ag1 = acc[ai][0][m][1], au0 = acc[ai][1][m][0], au1 = acc[ai][1][m][1];
                const float rsl = rs_ * -1.4426950408889634f, rs2 = rs_ * rs_;
                const f32x4 t0 = ag0 * rsl, t1 = ag1 * rsl; f32x4 e0, e1;
#pragma unroll
                for (int i = 0; i < 4; ++i) { e0[i] = __builtin_amdgcn_exp2f(t0[i]); e1[i] = __builtin_amdgcn_exp2f(t1[i]); }
                const f32x4 d0 = e0 + 1.0f, d1 = e1 + 1.0f; f32x4 r0, r1;
#pragma unroll
                for (int i = 0; i < 4; ++i) { r0[i] = __builtin_amdgcn_rcpf(d0[i]); r1[i] = __builtin_amdgcn_rcpf(d1[i]); }
                const f32x4 o0 = (ag0 * au0) * (r0 * rs2), o1 = (ag1 * au1) * (r1 * rs2);
                u32x4 w; w.x = cvt_pk_bf16(o0[0], o0[1]); w.y = cvt_pk_bf16(o0[2], o0[3]); w.z = cvt_pk_bf16(o1[0], o1[1]); w.w = cvt_pk_bf16(o1[2], o1[3]);
                *(u32x4*)rowp = w; }
    }
};
struct EpiResidBf {
    static constexpr bool PERM = true, AFTER_DRAIN = false, MIDSCALE = false;
    bf16_t* xb; int ldc; float alpha; unsigned long long* ss;
    __device__ __forceinline__ void operator()(const f32x4 (&acc)[2][2][4][2], const Unit& u, int wr, int wc, int fr, int fq) const {
        const int row0 = u.pm * BM + wr * 64 + fr, col0 = u.pn * BM + wc * 32 + 8 * fq;
        u32x4 b[2][4][2];
#pragma unroll
        for (int ai = 0; ai < 2; ++ai)
#pragma unroll
            for (int m = 0; m < 4; ++m)
#pragma unroll
                for (int bj = 0; bj < 2; ++bj) b[ai][m][bj] = *(const u32x4*)(xb + (size_t)(row0 + ai * HALF + m * 16) * ldc + col0 + bj * HALF);
#pragma unroll
        for (int ai = 0; ai < 2; ++ai)
#pragma unroll
            for (int m = 0; m < 4; ++m) { const int row = row0 + ai * HALF + m * 16; bf16_t* rowp = xb + (size_t)row * ldc + col0; float s = 0.f;
#pragma unroll
                for (int bj = 0; bj < 2; ++bj) { f32x4 v0, v1; const u32x4 bb = b[ai][m][bj];
                    v0[0] = __uint_as_float(bb.x << 16); v0[1] = __uint_as_float(bb.x & 0xffff0000u); v0[2] = __uint_as_float(bb.y << 16); v0[3] = __uint_as_float(bb.y & 0xffff0000u);
                    v1[0] = __uint_as_float(bb.z << 16); v1[1] = __uint_as_float(bb.z & 0xffff0000u); v1[2] = __uint_as_float(bb.w << 16); v1[3] = __uint_as_float(bb.w & 0xffff0000u);
                    v0 += acc[ai][bj][m][0] * alpha; v1 += acc[ai][bj][m][1] * alpha;
                    s += (v0[0] * v0[0] + v0[1] * v0[1]) + (v0[2] * v0[2] + v0[3] * v0[3]) + (v1[0] * v1[0] + v1[1] * v1[1]) + (v1[2] * v1[2] + v1[3] * v1[3]);
                    u32x4 w; w.x = cvt_pk_bf16(v0[0], v0[1]); w.y = cvt_pk_bf16(v0[2], v0[3]); w.z = cvt_pk_bf16(v1[0], v1[1]); w.w = cvt_pk_bf16(v1[2], v1[3]);
                    *(u32x4*)(rowp + bj * HALF) = w; }
                if (ss) { s += __shfl_xor(s, 16); s += __shfl_xor(s, 32);
                    if (fq == 0) __hip_atomic_fetch_add(ss + row, (unsigned long long)(s * SS_FIX + 0.5f), __ATOMIC_RELAXED, __HIP_MEMORY_SCOPE_AGENT); } }
    }
};
__device__ __forceinline__ float rstd2k_of(const unsigned long long* ss, int row) { const float s = (float)ss[row] * (1.0f / SS_FIX); return 1.0f / sqrtf(s * (1.0f / 2048.0f) + 1e-6f); }
struct EpiResidMid {
    static constexpr bool PERM = true, AFTER_DRAIN = false, MIDSCALE = true;
    bf16_t* xb; int ldc; unsigned long long* ss; const PG8_LAS float* tbl; int tpm; const unsigned long long* ssa; const unsigned long long* ssb;
    __device__ __forceinline__ void midscale(f32x4 (&acc)[2][2][4][2], const Unit& u, int wr, int fr) const {
        const bool inl = (u.pm == tpm); int rb_ = wr * 64 + fr; asm volatile("" : "+v"(rb_));
#pragma unroll
        for (int ai = 0; ai < 2; ++ai)
#pragma unroll
            for (int m = 0; m < 4; ++m) { const int ri = rb_ + ai * HALF + m * 16; float f;
                if (inl) f = tbl[ri]; else { const int row = u.pm * BM + ri; f = rstd2k_of(ssa, row) / rstd2k_of(ssb, row); }
#pragma unroll
                for (int bj = 0; bj < 2; ++bj)
#pragma unroll
                    for (int n = 0; n < 2; ++n) acc[ai][bj][m][n] *= f; }
    }
    __device__ __forceinline__ void operator()(const f32x4 (&acc)[2][2][4][2], const Unit& u, int wr, int wc, int fr, int fq) const {
        int rb_ = wr * 64 + fr; asm volatile("" : "+v"(rb_));
        const int row0 = u.pm * BM + rb_, col0 = u.pn * BM + wc * 32 + 8 * fq; const bool inl = (u.pm == tpm);
        u32x4 b[2][4][2];
#pragma unroll
        for (int ai = 0; ai < 2; ++ai)
#pragma unroll
            for (int m = 0; m < 4; ++m)
#pragma unroll
                for (int bj = 0; bj < 2; ++bj) b[ai][m][bj] = *(const u32x4*)(xb + (size_t)(row0 + ai * HALF + m * 16) * ldc + col0 + bj * HALF);
#pragma unroll
        for (int ai = 0; ai < 2; ++ai)
#pragma unroll
            for (int m = 0; m < 4; ++m) { const int row = row0 + ai * HALF + m * 16; bf16_t* rowp = xb + (size_t)row * ldc + col0; float s = 0.f; const float alpha = inl ? tbl[256 + rb_ + ai * HALF + m * 16] : rstd2k_of(ssb, row);
#pragma unroll
                for (int bj = 0; bj < 2; ++bj) { f32x4 v0, v1; const u32x4 bb = b[ai][m][bj];
                    v0[0] = __uint_as_float(bb.x << 16); v0[1] = __uint_as_float(bb.x & 0xffff0000u); v0[2] = __uint_as_float(bb.y << 16); v0[3] = __uint_as_float(bb.y & 0xffff0000u);
                    v1[0] = __uint_as_float(bb.z << 16); v1[1] = __uint_as_float(bb.z & 0xffff0000u); v1[2] = __uint_as_float(bb.w << 16); v1[3] = __uint_as_float(bb.w & 0xffff0000u);
                    v0 += acc[ai][bj][m][0] * alpha; v1 += acc[ai][bj][m][1] * alpha;
                    s += (v0[0] * v0[0] + v0[1] * v0[1]) + (v0[2] * v0[2] + v0[3] * v0[3]) + (v1[0] * v1[0] + v1[1] * v1[1]) + (v1[2] * v1[2] + v1[3] * v1[3]);
                    u32x4 w; w.x = cvt_pk_bf16(v0[0], v0[1]); w.y = cvt_pk_bf16(v0[2], v0[3]); w.z = cvt_pk_bf16(v1[0], v1[1]); w.w = cvt_pk_bf16(v1[2], v1[3]);
                    *(u32x4*)(rowp + bj * HALF) = w; }
                s += __shfl_xor(s, 16); s += __shfl_xor(s, 32);
                if (fq == 0) __hip_atomic_fetch_add(ss + row, (unsigned long long)(s * SS_FIX + 0.5f), __ATOMIC_RELAXED, __HIP_MEMORY_SCOPE_AGENT); }
    }
};
struct EpiF32Part {
    static constexpr bool PERM = false, AFTER_DRAIN = false, MIDSCALE = false;
    float* C; int ldc; size_t slice;
    __device__ __forceinline__ void operator()(const f32x4 (&acc)[2][2][4][2], const Unit& u, int wr, int wc, int fr, int fq) const {
        const int row0 = u.pm * BM + wr * 64 + fr, col0 = u.pn * BM + wc * 32 + 4 * fq; float* Cs = C + (size_t)u.ks * slice;
#pragma unroll
        for (int ai = 0; ai < 2; ++ai)
#pragma unroll
            for (int m = 0; m < 4; ++m) { float* rowp = Cs + (size_t)(row0 + ai * HALF + m * 16) * ldc + col0;
#pragma unroll
                for (int bj = 0; bj < 2; ++bj)
#pragma unroll
                    for (int n = 0; n < 2; ++n) *(f32x4*)(rowp + bj * HALF + n * 16) = acc[ai][bj][m][n]; }
    }
};
struct SplitK4Order {
    int v, G;
    __device__ bool next(int i, Unit& u) const { const int L = i * G + v; if (L >= 256) return false; u.pm = L >> 3; u.pn = (L >> 2) & 1; u.ks = L & 3; u.kofs = u.ks * 2048; return true; }
    __device__ __forceinline__ void a_ready(const Unit&) const {}
    __device__ __forceinline__ void done(const Unit&) const {}
};
struct KvOrder {
    int c;
    __device__ bool next(int i, Unit& u) const { if (i != 0 || c < 0 || c >= 8) return false; u.pm = c >> 2; u.pn = c; u.ks = 0; u.kofs = 0; return true; }
    __device__ __forceinline__ void a_ready(const Unit&) const {}
    __device__ __forceinline__ void done(const Unit&) const {}
};
template <class Epi, class Sched, bool ALIGN_EPI = false, bool SP2 = false>
__device__ __forceinline__ void gemm_phase(PG8_LAS unsigned char* lds, const Gemm g, const Sched& S, const Epi& E) {
    const int tid = opaque_tid(), wid = __builtin_amdgcn_readfirstlane(tid >> 6), lane = tid & 63, wr = wid >> 2, wc = wid & 3, fr = lane & 15, fq = lane >> 4;
    const int K = g.K, nt = K / BK;
    unsigned voffA[2], voffB[2];
#pragma unroll
    for (int i = 0; i < 2; ++i) { int R, C; stage_rc(tid * 16 + i * 8192, R, C); const int Rb = Epi::PERM ? ((R & ~31) + perm32(R & 31)) : R;
        voffA[i] = (unsigned)(R * g.ld + C) * 2u; voffB[i] = (unsigned)(Rb * g.ld + C) * 2u; }
    const size_t kstep = (size_t)(BK * 2);
    const size_t hstep = (size_t)HALF * g.ld * 2;
    const size_t tstep = 2 * hstep;
    const unsigned ldsw = (unsigned)wid * 1024u;
    const int aoff = lds_byte(wr * 64 + fr, fq * 8), boff = lds_byte(wc * 32 + fr, fq * 8);
#define PG8_SA(b, h) (((b) * 2 + (h)) * HTB)
#define PG8_SB(b, h) ((4 + (b) * 2 + (h)) * HTB)
#define PG8_STAGE(bufoff, gbase, voff) do { _Pragma("unroll") for (int _i = 0; _i < 2; ++_i) \
        __builtin_amdgcn_global_load_lds((const unsigned*)((const char*)(gbase) + (voff)[_i]), (PG8_LAS unsigned*)(lds + (bufoff) + ldsw + _i * 8192), 16, 0, 0); } while (0)
#define PG8_LDA(dst, b, h) do { _Pragma("unroll") for (int m = 0; m < 4; ++m) _Pragma("unroll") for (int k = 0; k < 2; ++k) dst[m][k] = *(const PG8_LAS bf16x8*)(lds + PG8_SA(b, h) + aoff + m * 2048 + k * 1024); } while (0)
#define PG8_LDB(dst, b, h) do { _Pragma("unroll") for (int n = 0; n < 2; ++n) _Pragma("unroll") for (int k = 0; k < 2; ++k) dst[n][k] = *(const PG8_LAS bf16x8*)(lds + PG8_SB(b, h) + boff + n * 2048 + k * 1024); } while (0)
#define PG8_MMA(ai, bj, At, Bt) do { __builtin_amdgcn_s_setprio(1); _Pragma("unroll") for (int m = 0; m < 4; ++m) _Pragma("unroll") for (int n = 0; n < 2; ++n) _Pragma("unroll") for (int k = 0; k < 2; ++k) \
        acc[ai][bj][m][n] = __builtin_amdgcn_mfma_f32_16x16x32_bf16(Bt[n][k], At[m][k], acc[ai][bj][m][n], 0, 0, 0); __builtin_amdgcn_s_setprio(0); } while (0)
#define PG8_WAIT_V(n) asm volatile("s_waitcnt vmcnt(" #n ")" ::: "memory")
#define PG8_WAIT_L(n) asm volatile("s_waitcnt lgkmcnt(" #n ")" ::: "memory")
#define PG8_BAR __builtin_amdgcn_s_barrier()
#define PG8_SCHED __builtin_amdgcn_sched_barrier(0)
    Unit cur, nxt; int ui = 0;
    if (!S.next(0, cur)) return;
    f32x4 acc[2][2][4][2];
#pragma unroll
    for (int a = 0; a < 2; ++a)
#pragma unroll
        for (int b = 0; b < 2; ++b)
#pragma unroll
            for (int m = 0; m < 4; ++m)
#pragma unroll
                for (int n = 0; n < 2; ++n) acc[a][b][m][n] = (f32x4){0.f, 0.f, 0.f, 0.f};
    bf16x8 At[4][2], B0[2][2], B1[2][2];
    const char* cA = (const char*)g.A + (size_t)cur.pm * tstep + cur.kofs; const char* cB = (const char*)g.Bt + (size_t)cur.pn * tstep + cur.kofs;
    S.a_ready(cur);
    if constexpr (SP2) {
        PG8_STAGE(PG8_SB(0, 0), cB, voffB); PG8_STAGE(PG8_SB(0, 1), cB + hstep, voffB); PG8_STAGE(PG8_SA(0, 0), cA, voffA); PG8_STAGE(PG8_SA(0, 1), cA + hstep, voffA);
        if (wr == 1) PG8_BAR;
        PG8_WAIT_V(2); PG8_BAR;
        PG8_STAGE(PG8_SB(1, 0), cB + kstep, voffB); PG8_STAGE(PG8_SA(1, 0), cA + kstep, voffA); PG8_STAGE(PG8_SB(1, 1), cB + hstep + kstep, voffB);
        PG8_WAIT_V(6); PG8_BAR;
    } else {
        PG8_STAGE(PG8_SB(0, 0), cB, voffB); PG8_STAGE(PG8_SA(0, 0), cA, voffA); PG8_STAGE(PG8_SB(0, 1), cB + hstep, voffB); PG8_STAGE(PG8_SA(0, 1), cA + hstep, voffA);
        if (wr == 1) PG8_BAR;
        PG8_WAIT_V(4); PG8_BAR;
        PG8_STAGE(PG8_SB(1, 0), cB + kstep, voffB); PG8_STAGE(PG8_SA(1, 0), cA + kstep, voffA); PG8_STAGE(PG8_SB(1, 1), cB + hstep + kstep, voffB);
        PG8_WAIT_V(6); PG8_BAR;
    }
    for (;;) {
        const bool has_next = S.next(ui + 1, nxt);
        const char* nA = has_next ? (const char*)g.A + (size_t)nxt.pm * tstep + nxt.kofs : cA; const char* nB = has_next ? (const char*)g.Bt + (size_t)nxt.pn * tstep + nxt.kofs : cB;
        _Pragma("clang loop unroll(disable)") for (int th = 0; th < (Epi::MIDSCALE ? 2 : 1); ++th) {
        const int tb = Epi::MIDSCALE ? th * (nt >> 1) : 0, te = Epi::MIDSCALE ? tb + (nt >> 1) : nt;
        for (int t = tb; t < te; t += 2) {
            const bool last = (t == nt - 2);
            const char* a1 = cA + (size_t)(t + 1) * kstep;
            const char* a2 = last ? nA : cA + (size_t)(t + 2) * kstep; const char* b2 = last ? nB : cB + (size_t)(t + 2) * kstep;
            const char* a3 = a2 + kstep; const char* b3 = b2 + kstep;
            if (last && has_next) S.a_ready(nxt);
            if constexpr (SP2) {
            PG8_LDB(B0, 0, 0); PG8_LDB(B1, 0, 1); PG8_SCHED; PG8_LDA(At, 0, 0); PG8_STAGE(PG8_SA(1, 1), a1 + hstep, voffA);
            PG8_WAIT_V(8); PG8_WAIT_L(0); PG8_BAR; PG8_MMA(0, 0, At, B0); PG8_MMA(0, 1, At, B1); PG8_BAR; PG8_SCHED;
            PG8_LDA(At, 0, 1); PG8_STAGE(PG8_SB(0, 0), b2, voffB); PG8_STAGE(PG8_SB(0, 1), b2 + hstep, voffB); PG8_STAGE(PG8_SA(0, 0), a2, voffA);
            PG8_WAIT_V(8); PG8_WAIT_L(0); PG8_BAR; PG8_MMA(1, 0, At, B0); PG8_MMA(1, 1, At, B1); PG8_BAR; PG8_SCHED;
            PG8_LDB(B0, 1, 0); PG8_LDB(B1, 1, 1); PG8_SCHED; PG8_LDA(At, 1, 0); PG8_STAGE(PG8_SA(0, 1), a2 + hstep, voffA);
            PG8_WAIT_V(8); PG8_WAIT_L(0); PG8_BAR; PG8_MMA(0, 0, At, B0); PG8_MMA(0, 1, At, B1); PG8_BAR; PG8_SCHED;
            PG8_LDA(At, 1, 1); PG8_STAGE(PG8_SB(1, 0), b3, voffB); PG8_STAGE(PG8_SB(1, 1), b3 + hstep, voffB); PG8_STAGE(PG8_SA(1, 0), a3, voffA);
            PG8_WAIT_V(8); PG8_WAIT_L(0); PG8_BAR; PG8_MMA(1, 0, At, B0); PG8_MMA(1, 1, At, B1); PG8_BAR; PG8_SCHED;
            } else {
            PG8_LDB(B0, 0, 0); PG8_SCHED; PG8_LDA(At, 0, 0); PG8_STAGE(PG8_SA(1, 1), a1 + hstep, voffA);
            PG8_WAIT_L(8); PG8_BAR; PG8_WAIT_L(0); PG8_MMA(0, 0, At, B0); PG8_BAR; PG8_SCHED;
            PG8_LDB(B1, 0, 1); PG8_STAGE(PG8_SB(0, 0), b2, voffB);
            PG8_BAR; PG8_WAIT_L(0); PG8_MMA(0, 1, At, B1); PG8_BAR;
            PG8_LDA(At, 0, 1); PG8_STAGE(PG8_SA(0, 0), a2, voffA);
            PG8_BAR; PG8_WAIT_L(0); PG8_MMA(1, 0, At, B0); PG8_BAR; PG8_SCHED;
            PG8_STAGE(PG8_SB(0, 1), b2 + hstep, voffB);
            PG8_WAIT_V(6); PG8_BAR; PG8_MMA(1, 1, At, B1); PG8_BAR;
            PG8_LDB(B0, 1, 0); PG8_SCHED; PG8_LDA(At, 1, 0); PG8_STAGE(PG8_SA(0, 1), a2 + hstep, voffA);
            PG8_WAIT_L(8); PG8_BAR; PG8_WAIT_L(0); PG8_MMA(0, 0, At, B0); PG8_BAR; PG8_SCHED;
            PG8_LDB(B1, 1, 1); PG8_STAGE(PG8_SB(1, 0), b3, voffB);
            PG8_BAR; PG8_WAIT_L(0); PG8_MMA(0, 1, At, B1); PG8_BAR;
            PG8_LDA(At, 1, 1); PG8_STAGE(PG8_SA(1, 0), a3, voffA);
            PG8_BAR; PG8_WAIT_L(0); PG8_MMA(1, 0, At, B0); PG8_BAR; PG8_SCHED;
            PG8_STAGE(PG8_SB(1, 1), b3 + hstep, voffB);
            PG8_WAIT_V(6); PG8_BAR; PG8_MMA(1, 1, At, B1); PG8_BAR;
            }
        }
        if constexpr (Epi::MIDSCALE) { if (th == 0) { PG8_SCHED; E.midscale(acc, cur, wr, fr); PG8_SCHED; } }
        }
        if constexpr (ALIGN_EPI) { if (wr == 0) PG8_BAR; }
        if constexpr (!Epi::AFTER_DRAIN) { E(acc, cur, wr, wc, fr, fq); S.done(cur); }
        if (!has_next) break;
#pragma unroll
        for (int a = 0; a < 2; ++a)
#pragma unroll
            for (int b = 0; b < 2; ++b)
#pragma unroll
                for (int m = 0; m < 4; ++m)
#pragma unroll
                    for (int n = 0; n < 2; ++n) acc[a][b][m][n] = (f32x4){0.f, 0.f, 0.f, 0.f};
        cur = nxt; cA = nA; cB = nB; ++ui;
        if constexpr (ALIGN_EPI) { if (wr == 1) PG8_BAR; }
    }
    PG8_WAIT_V(0);
    if constexpr (!ALIGN_EPI) { if (wr == 0) PG8_BAR; }
    PG8_BAR;
    if constexpr (Epi::AFTER_DRAIN) { E.fused(acc, cur, wr, wc, fr, fq, lds, wid, lane); S.done(cur); }
#undef PG8_SA
#undef PG8_SB
#undef PG8_STAGE
#undef PG8_LDA
#undef PG8_LDB
#undef PG8_MMA
#undef PG8_WAIT_V
#undef PG8_WAIT_L
#undef PG8_BAR
#undef PG8_SCHED
}
}
namespace att {
typedef unsigned short bf16;
constexpr int   D = 128, NW = 8, QBLK = 32, KVBLK = 64;
constexpr float SCALE = 0.088388347648318440f;
constexpr float THR = 8.f;
constexpr size_t SHM_V = KVBLK * D * 2, SHM_K = KVBLK * D * 2, SHM_ATTN = 2 * SHM_V + 2 * SHM_K + NW * 64 * 4;
using bf16x8 = __attribute__((ext_vector_type(8))) short;
using s16x4  = __attribute__((ext_vector_type(4))) short;
using f32x16 = __attribute__((ext_vector_type(16))) float;
using u32x4  = __attribute__((ext_vector_type(4))) unsigned;
using f32x4  = __attribute__((ext_vector_type(4))) float;
#define KSWZ(row, colB) ((row) * 256 + ((colB) ^ (((row) & 7) << 4)))
#define SBAR() __builtin_amdgcn_sched_barrier(0)
#ifndef ATT_PRESCALED
#define ATT_PRESCALED 1
#endif
__device__ __forceinline__ int crow(int r, int hi) { return (r & 3) + 8 * (r >> 2) + 4 * hi; }
__device__ __forceinline__ unsigned cvtpk(float lo, float hi) {
  unsigned r; asm volatile("v_cvt_pk_bf16_f32 %0, %1, %2" : "=v"(r) : "v"(lo), "v"(hi)); return r;
}
__device__ __forceinline__ bf16x8 ld8(const bf16* p) { return *reinterpret_cast<const bf16x8*>(p); }

__device__ __forceinline__ void partialSM(f32x16& p0, f32x16& p1, float& m_reg, float& mn, float& alpha) {
  constexpr float C = SCALE * 1.4426950408889634f;
  float pmax = p0[0]; for (int r = 1; r < 16; ++r) pmax = fmaxf(pmax, p0[r]); for (int r = 0; r < 16; ++r) pmax = fmaxf(pmax, p1[r]);
  { auto rr = __builtin_amdgcn_permlane32_swap(__float_as_uint(pmax), __float_as_uint(pmax), false, false);
    pmax = fmaxf(__uint_as_float(rr[0]), __uint_as_float(rr[1])); }
  if (__builtin_expect(__all(pmax - m_reg <= THR / SCALE), 1)) { mn = m_reg; alpha = 1.f; }
  else { mn = fmaxf(m_reg, pmax); alpha = __builtin_amdgcn_exp2f((m_reg - mn) * C); m_reg = mn; }
  float mnC = -mn * C;
  for (int r = 0; r < 16; ++r) p0[r] = fmaf(p0[r], C, mnC); for (int r = 0; r < 16; ++r) p1[r] = fmaf(p1[r], C, mnC);
  for (int r = 0; r < 16; ++r) p0[r] = __builtin_amdgcn_exp2f(p0[r]);
}
__device__ __forceinline__ void partialSM_fixed(f32x16& p0, f32x16& p1, float negb2) {
#if ATT_PRESCALED
  if (negb2 != 0.f) { for (int r = 0; r < 16; ++r) p0[r] += negb2; for (int r = 0; r < 16; ++r) p1[r] += negb2; }
#else
  constexpr float C = SCALE * 1.4426950408889634f;
  for (int r = 0; r < 16; ++r) p0[r] = fmaf(p0[r], C, negb2); for (int r = 0; r < 16; ++r) p1[r] = fmaf(p1[r], C, negb2);
#endif
  for (int r = 0; r < 16; ++r) p0[r] = __builtin_amdgcn_exp2f(p0[r]);
}
__device__ __forceinline__ void finishSM(f32x16& p0, f32x16& p1, float alpha, float& l_reg, bf16x8& pa0, bf16x8& pa1, bf16x8& pa2, bf16x8& pa3) {
  for (int r = 0; r < 16; ++r) p1[r] = __builtin_amdgcn_exp2f(p1[r]);
  float ps = 0; for (int r = 0; r < 16; ++r) ps += p0[r]; for (int r = 0; r < 16; ++r) ps += p1[r];
  { auto rr = __builtin_amdgcn_permlane32_swap(__float_as_uint(ps), __float_as_uint(ps), false, false);
    ps = __uint_as_float(rr[0]) + __uint_as_float(rr[1]); }
  l_reg = l_reg * alpha + ps;
#define PK4(P, BASE, OUT) do { unsigned a0 = cvtpk(P[BASE + 0], P[BASE + 1]), a1 = cvtpk(P[BASE + 2], P[BASE + 3]);   \
    unsigned b0 = cvtpk(P[BASE + 4], P[BASE + 5]), b1 = cvtpk(P[BASE + 6], P[BASE + 7]);                              \
    auto r0 = __builtin_amdgcn_permlane32_swap(a0, b0, false, false); auto r1 = __builtin_amdgcn_permlane32_swap(a1, b1, false, false); \
    u32x4 w = {r0[0], r1[0], r0[1], r1[1]}; OUT = *reinterpret_cast<bf16x8*>(&w); } while (0)
  PK4(p0, 0, pa0); PK4(p0, 8, pa1); PK4(p1, 0, pa2); PK4(p1, 8, pa3);
#undef PK4
}
__device__ __forceinline__ void finishSM_fixed(f32x16& p0, f32x16& p1, bf16x8& pa0, bf16x8& pa1, bf16x8& pa2, bf16x8& pa3) {
  for (int r = 0; r < 16; ++r) p1[r] = __builtin_amdgcn_exp2f(p1[r]);
#define PK4(P, BASE, OUT) do { unsigned a0 = cvtpk(P[BASE + 0], P[BASE + 1]), a1 = cvtpk(P[BASE + 2], P[BASE + 3]);   \
    unsigned b0 = cvtpk(P[BASE + 4], P[BASE + 5]), b1 = cvtpk(P[BASE + 6], P[BASE + 7]);                              \
    auto r0 = __builtin_amdgcn_permlane32_swap(a0, b0, false, false); auto r1 = __builtin_amdgcn_permlane32_swap(a1, b1, false, false); \
    u32x4 w = {r0[0], r1[0], r0[1], r1[1]}; OUT = *reinterpret_cast<bf16x8*>(&w); } while (0)
  PK4(p0, 0, pa0); PK4(p0, 8, pa1); PK4(p1, 0, pa2); PK4(p1, 8, pa3);
#undef PK4
}
__device__ __forceinline__ void qkt(f32x16& p0, f32x16& p1, const bf16* Ks, const bf16x8* qr, int r32, int hi) {
  p0 = f32x16{}; p1 = f32x16{};
  for (int d0 = 0; d0 < 8; ++d0) { int cb = (d0 * 16 + hi * 8) * 2;
    bf16x8 b0 = *reinterpret_cast<const bf16x8*>((const char*)Ks + KSWZ(r32, cb));
    bf16x8 b1 = *reinterpret_cast<const bf16x8*>((const char*)Ks + KSWZ(32 + r32, cb));
    p0 = __builtin_amdgcn_mfma_f32_32x32x16_bf16(b0, qr[d0], p0, 0, 0, 0);
    p1 = __builtin_amdgcn_mfma_f32_32x32x16_bf16(b1, qr[d0], p1, 0, 0, 0); }
}
__device__ __forceinline__ int v_st(int k, int c) { const int kk = (k & ~0xC) | ((k & 4) << 1) | ((k & 8) >> 1); return ((kk >> 3) * 4 + (c >> 5)) * 512 + ((kk & 7) * 32 + (c & 31)) * 2; }
__device__ __forceinline__ int v_rd_base(int lane) { return ((lane & 3) << 3) | (((lane >> 2) & 3) << 6) | (((lane >> 4) & 1) << 5) | (((lane >> 5) & 1) << 8); }
constexpr int v_rd_off(int d0, int ks, int half) { return d0 * 512 + ks * 4096 + half * 2048; }
template <int OFF> __device__ __forceinline__ s16x4 tr_read(int vb) {
  s16x4 r; asm volatile("ds_read_b64_tr_b16 %0, %1 offset:%2" : "=&v"(r) : "v"(vb), "i"(OFF) : "memory"); return r;
}
template <int D0, bool LSUM = false> __device__ __forceinline__ void pv_one(f32x16& od, int vb, bf16x8 pa0, bf16x8 pa1, bf16x8 pa2, bf16x8 pa3, f32x4* ol = nullptr, bf16x8 osel = bf16x8{}) {
  const s16x4 l0 = tr_read<v_rd_off(D0, 0, 0)>(vb), h0 = tr_read<v_rd_off(D0, 0, 1)>(vb), l1 = tr_read<v_rd_off(D0, 1, 0)>(vb), h1 = tr_read<v_rd_off(D0, 1, 1)>(vb);
  const s16x4 l2 = tr_read<v_rd_off(D0, 2, 0)>(vb), h2 = tr_read<v_rd_off(D0, 2, 1)>(vb), l3 = tr_read<v_rd_off(D0, 3, 0)>(vb), h3 = tr_read<v_rd_off(D0, 3, 1)>(vb);
  if constexpr (LSUM)
    *ol = __builtin_amdgcn_mfma_f32_16x16x32_bf16(D0 == 0 ? pa0 : D0 == 1 ? pa1 : D0 == 2 ? pa2 : pa3, osel, *ol, 0, 0, 0);
  asm volatile("s_waitcnt lgkmcnt(0)" ::: "memory"); SBAR();
#define PK(L, H) (bf16x8){L[0], L[1], L[2], L[3], H[0], H[1], H[2], H[3]}
  od = __builtin_amdgcn_mfma_f32_32x32x16_bf16(pa0, PK(l0, h0), od, 0, 0, 0);
  od = __builtin_amdgcn_mfma_f32_32x32x16_bf16(pa1, PK(l1, h1), od, 0, 0, 0);
  od = __builtin_amdgcn_mfma_f32_32x32x16_bf16(pa2, PK(l2, h2), od, 0, 0, 0);
  od = __builtin_amdgcn_mfma_f32_32x32x16_bf16(pa3, PK(l3, h3), od, 0, 0, 0);
#undef PK
}
template <bool LSUM = false> __device__ __forceinline__ void pv_d0(f32x16* o, int vb, bf16x8 pa0, bf16x8 pa1, bf16x8 pa2, bf16x8 pa3, f32x4* ol = nullptr, bf16x8 osel = bf16x8{}) {
  pv_one<0, LSUM>(o[0], vb, pa0, pa1, pa2, pa3, ol, osel); pv_one<1, LSUM>(o[1], vb, pa0, pa1, pa2, pa3, ol, osel); pv_one<2, LSUM>(o[2], vb, pa0, pa1, pa2, pa3, ol, osel); pv_one<3, LSUM>(o[3], vb, pa0, pa1, pa2, pa3, ol, osel);
}

#define PKA(P, BASE) do { ta0 = cvtpk(P[BASE + 0], P[BASE + 1]); ta1 = cvtpk(P[BASE + 2], P[BASE + 3]); } while (0)
#define PKB(P, BASE) do { tb0 = cvtpk(P[BASE + 4], P[BASE + 5]); tb1 = cvtpk(P[BASE + 6], P[BASE + 7]); } while (0)
#define PKC(OUT) do { auto r0 = __builtin_amdgcn_permlane32_swap(ta0, tb0, false, false); auto r1 = __builtin_amdgcn_permlane32_swap(ta1, tb1, false, false); \
    u32x4 w = {r0[0], r1[0], r0[1], r1[1]}; OUT = *reinterpret_cast<bf16x8*>(&w); } while (0)
__device__ __forceinline__ void qkt_fin(f32x16& n0, f32x16& n1, const bf16* Ks, const bf16x8* qr, int r32, int hi, f32x16& o0, f32x16& o1, bf16x8& pa0, bf16x8& pa1, bf16x8& pa2, bf16x8& pa3) {
  n0 = f32x16{}; n1 = f32x16{};
  bf16x8 kb[2][2]; unsigned ta0 = 0, ta1 = 0, tb0 = 0, tb1 = 0;
#define KLD(d0_, half_) do { const int cb = ((d0_) * 16 + hi * 8) * 2; kb[(d0_) & 1][half_] = *reinterpret_cast<const bf16x8*>((const char*)Ks + KSWZ((half_) * 32 + r32, cb)); } while (0)
#define EX(i_) o1[i_] = __builtin_amdgcn_exp2f(o1[i_])
  KLD(0, 0); KLD(0, 1); KLD(1, 0);
#pragma unroll
  for (int d0 = 0; d0 < 8; ++d0) {
    if (d0 + 1 < 8) KLD(d0 + 1, 1);
    n0 = __builtin_amdgcn_mfma_f32_32x32x16_bf16(kb[d0 & 1][0], qr[d0], n0, 0, 0, 0);
    { const int g = 2 * d0;
      if (g >= 4 && g < 12) { EX(2 * (g - 4)); EX(2 * (g - 4) + 1); }
      if (g == 4) PKA(o0, 0); if (g == 6) PKC(pa0); if (g == 8) PKB(o0, 8); if (g == 10) PKA(o1, 0); if (g == 12) { PKC(pa2); PKA(o1, 8); } if (g == 14) PKC(pa3); }
    SBAR();
    if (d0 + 2 < 8) KLD(d0 + 2, 0);
    n1 = __builtin_amdgcn_mfma_f32_32x32x16_bf16(kb[d0 & 1][1], qr[d0], n1, 0, 0, 0);
    { const int g = 2 * d0 + 1;
      if (g >= 4 && g < 12) { EX(2 * (g - 4)); EX(2 * (g - 4) + 1); }
      if (g == 5) PKB(o0, 0); if (g == 7) PKA(o0, 8); if (g == 9) PKC(pa1); if (g == 11) PKB(o1, 0); if (g == 13) PKB(o1, 8); }
    SBAR();
  }
#undef KLD
#undef EX
}
#undef PKA
#undef PKB
#undef PKC
template <int D0> __device__ __forceinline__ void pv_one_x(f32x16& od, int vb, bf16x8 pa0, bf16x8 pa1, bf16x8 pa2, bf16x8 pa3, f32x4& ol, bf16x8 osel, f32x16& n0) {
  const s16x4 l0 = tr_read<v_rd_off(D0, 0, 0)>(vb), h0 = tr_read<v_rd_off(D0, 0, 1)>(vb), l1 = tr_read<v_rd_off(D0, 1, 0)>(vb), h1 = tr_read<v_rd_off(D0, 1, 1)>(vb);
  const s16x4 l2 = tr_read<v_rd_off(D0, 2, 0)>(vb), h2 = tr_read<v_rd_off(D0, 2, 1)>(vb), l3 = tr_read<v_rd_off(D0, 3, 0)>(vb), h3 = tr_read<v_rd_off(D0, 3, 1)>(vb);
  ol = __builtin_amdgcn_mfma_f32_16x16x32_bf16(D0 == 0 ? pa0 : D0 == 1 ? pa1 : D0 == 2 ? pa2 : pa3, osel, ol, 0, 0, 0);
  n0[4 * D0] = __builtin_amdgcn_exp2f(n0[4 * D0]);
  asm volatile("s_waitcnt lgkmcnt(0)" ::: "memory"); SBAR();
#define PK(L, H) (bf16x8){L[0], L[1], L[2], L[3], H[0], H[1], H[2], H[3]}
  od = __builtin_amdgcn_mfma_f32_32x32x16_bf16(pa0, PK(l0, h0), od, 0, 0, 0); n0[4 * D0 + 1] = __builtin_amdgcn_exp2f(n0[4 * D0 + 1]); SBAR();
  od = __builtin_amdgcn_mfma_f32_32x32x16_bf16(pa1, PK(l1, h1), od, 0, 0, 0); n0[4 * D0 + 2] = __builtin_amdgcn_exp2f(n0[4 * D0 + 2]); SBAR();
  od = __builtin_amdgcn_mfma_f32_32x32x16_bf16(pa2, PK(l2, h2), od, 0, 0, 0); n0[4 * D0 + 3] = __builtin_amdgcn_exp2f(n0[4 * D0 + 3]); SBAR();
  od = __builtin_amdgcn_mfma_f32_32x32x16_bf16(pa3, PK(l3, h3), od, 0, 0, 0);
#undef PK
}
__device__ __forceinline__ void pv_exp(f32x16* o, int vb, bf16x8 pa0, bf16x8 pa1, bf16x8 pa2, bf16x8 pa3, f32x4& ol, bf16x8 osel, f32x16& n0, f32x16& n1, float negb2) {
  if (negb2 != 0.f) { for (int r = 0; r < 16; ++r) n0[r] += negb2; for (int r = 0; r < 16; ++r) n1[r] += negb2; }
  pv_one_x<0>(o[0], vb, pa0, pa1, pa2, pa3, ol, osel, n0); pv_one_x<1>(o[1], vb, pa0, pa1, pa2, pa3, ol, osel, n0); pv_one_x<2>(o[2], vb, pa0, pa1, pa2, pa3, ol, osel, n0); pv_one_x<3>(o[3], vb, pa0, pa1, pa2, pa3, ol, osel, n0);
}
struct BfQ { const bf16* p; int ld;
  __device__ __forceinline__ bf16x8 operator()(int r, int d) const { return ld8(p + (long)r * ld + d); } };
struct NoHook { __device__ __forceinline__ void operator()(f32x16&, f32x16&, int, int, int, int) const {} };

template <int LDK, int LDO, int SDEPTH, bool FIXM, class QLoad, class Hook, bool ODDNT = false>
__device__ __forceinline__ void attn_dense_body(const QLoad& ql, const bf16* __restrict__ Kh, const bf16* __restrict__ Vh,
                                                bf16* __restrict__ Ob, int seq, char* lds, const Hook& hook, unsigned long long* ssrow = nullptr, float negb2 = 0.f) {
  const int tid = opaque_tid(), wid = tid >> 6, lane = tid & 63, r32 = lane & 31, hi = lane >> 5;
  bf16* V_lds = (bf16*)lds; bf16* K_lds = (bf16*)(lds + 2 * SHM_V);
  float* ws = (float*)(lds + ((FIXM && ATT_PRESCALED) ? 6 : 4) * SHM_V) + wid * 64; float* li_l = ws; float* al_l = ws + 32;
  float m_reg = -1e30f, l_reg = 0; f32x16 o[4] = {}; f32x4 ol = {}; bf16x8 qr[8];
  bf16x8 osel; { const short ov = (((lane >> 4) & 1) == ((lane >> 3) & 1)) ? (short)0x3F80 : (short)0; osel = bf16x8{ov, ov, ov, ov, ov, ov, ov, ov}; }
#pragma unroll
  for (int d0 = 0; d0 < 8; ++d0) qr[d0] = ql(wid * QBLK + r32, hi * 8 + d0 * 16);
  const int sr = tid >> 4, sc = (tid & 15) * 8, vst0 = v_st(sr, sc), vst1 = v_st(32 + sr, sc);
  const int vb0 = (int)(uintptr_t)V_lds + v_rd_base(lane);
  struct { bf16x8 vs0, vs1, ks0, ks1; } sr_[SDEPTH];
#define SLOAD(i, k0) do { sr_[i].vs0 = ld8(&Vh[(long)((k0) + sr) * LDK + sc]); sr_[i].vs1 = ld8(&Vh[(long)((k0) + 32 + sr) * LDK + sc]); \
    sr_[i].ks0 = ld8(&Kh[(long)((k0) + sr) * LDK + sc]); sr_[i].ks1 = ld8(&Kh[(long)((k0) + 32 + sr) * LDK + sc]); } while (0)
#define SWRITE(b, i) do { *(bf16x8*)((char*)V_lds + (b) * SHM_V + vst0) = sr_[i].vs0;          \
    *(bf16x8*)((char*)V_lds + (b) * SHM_V + vst1) = sr_[i].vs1; int kc = sc * 2;               \
    *(bf16x8*)((char*)K_lds + (b) * SHM_K + KSWZ(sr, kc)) = sr_[i].ks0;                       \
    *(bf16x8*)((char*)K_lds + (b) * SHM_K + KSWZ(32 + sr, kc)) = sr_[i].ks1; } while (0)
#define SWAIT() do { if constexpr (SDEPTH == 2) asm volatile("s_waitcnt vmcnt(4)" ::: "memory"); else asm volatile("s_waitcnt vmcnt(0)" ::: "memory"); } while (0)
#define RESC(a) do { if (__any((a) < 1.f)) { if (hi == 0) al_l[r32] = (a); asm volatile("s_waitcnt lgkmcnt(0)" ::: "memory"); \
    for (int d = 0; d < 4; ++d) for (int r = 0; r < 16; ++r) o[d][r] *= al_l[crow(r, hi)]; } } while (0)
#define PSM(P0, P1, MN, AL) do { if constexpr (FIXM) { partialSM_fixed(P0, P1, negb2); AL = 1.f; } else partialSM(P0, P1, m_reg, MN, AL); } while (0)
#define RESCF(a) do { if constexpr (!FIXM) RESC(a); } while (0)
#define FSM(P0, P1, AL) do { if constexpr (FIXM) finishSM_fixed(P0, P1, pa0, pa1, pa2, pa3); else finishSM(P0, P1, AL, l_reg, pa0, pa1, pa2, pa3); } while (0)
  f32x16 pA0, pA1, pB0, pB1; float mnA, mnB, alA, alB; bf16x8 pa0, pa1, pa2, pa3; const int NT = seq / KVBLK;
  constexpr int SE = 0, SO = SDEPTH - 1;
  if constexpr (FIXM && ATT_PRESCALED) {
    typedef __attribute__((address_space(3))) unsigned* lds_u32p;
    char* const V3 = lds; char* const K3 = lds + 3 * SHM_V; const int vb3 = (int)(uintptr_t)V3 + v_rd_base(lane);
    int kof[2], vof[2];
#pragma unroll
    for (int i = 0; i < 2; ++i) { const int p = wid * 2 + i;
      { const int row = 4 * p + (lane >> 4), cg = (lane & 15) ^ (row & 7); kof[i] = row * LDK + cg * 8; }
      { const int st = 2 * p + (lane >> 5), kk = (st >> 2) * 8 + ((lane & 31) >> 2), k = (kk & ~0xC) | ((kk & 4) << 1) | ((kk & 8) >> 1), c = (st & 3) * 32 + (lane & 3) * 8; vof[i] = k * LDK + c; } }
    const unsigned ldsp = (unsigned)wid * 2048u;
#define DMA3(b, k0) do { const bf16* kg = Kh + (long)(k0) * LDK; const bf16* vg = Vh + (long)(k0) * LDK; _Pragma("unroll") for (int i_ = 0; i_ < 2; ++i_) { \
      __builtin_amdgcn_global_load_lds((const unsigned*)(kg + kof[i_]), (lds_u32p)(K3 + (b) * (int)SHM_K + ldsp + i_ * 1024), 16, 0, 0); \
      __builtin_amdgcn_global_load_lds((const unsigned*)(vg + vof[i_]), (lds_u32p)(V3 + (b) * (int)SHM_V + ldsp + i_ * 1024), 16, 0, 0); } } while (0)
#define VMW0() asm volatile("s_waitcnt vmcnt(0)" ::: "memory")
    DMA3(0, 0); DMA3(1, KVBLK); VMW0(); __syncthreads();
    qkt(pA0, pA1, (const bf16*)K3, qr, r32, hi); PSM(pA0, pA1, mnA, alA);
    int bj = 1;
    for (int j = 1; j + 1 < NT; j += 2) {
      const int b0_ = bj, b1_ = bj == 2 ? 0 : bj + 1, b2_ = b1_ == 2 ? 0 : b1_ + 1, bm_ = bj == 0 ? 2 : bj - 1;
      DMA3(b1_, (j + 1) * KVBLK);
      SBAR(); qkt_fin(pB0, pB1, (const bf16*)(K3 + b0_ * (int)SHM_K), qr, r32, hi, pA0, pA1, pa0, pa1, pa2, pa3); SBAR();
      pv_exp(o, vb3 + bm_ * (int)SHM_V, pa0, pa1, pa2, pa3, ol, osel, pB0, pB1, negb2);
      VMW0(); __syncthreads();
      if (j + 2 < NT) DMA3(b2_, (j + 2) * KVBLK);
      SBAR(); qkt_fin(pA0, pA1, (const bf16*)(K3 + b1_ * (int)SHM_K), qr, r32, hi, pB0, pB1, pa0, pa1, pa2, pa3); SBAR();
      pv_exp(o, vb3 + b0_ * (int)SHM_V, pa0, pa1, pa2, pa3, ol, osel, pA0, pA1, negb2);
      VMW0(); __syncthreads();
      bj = b2_;
    }
    { const int b0_ = bj, bm_ = bj == 0 ? 2 : bj - 1;
      SBAR(); qkt_fin(pB0, pB1, (const bf16*)(K3 + b0_ * (int)SHM_K), qr, r32, hi, pA0, pA1, pa0, pa1, pa2, pa3); SBAR();
      pv_exp(o, vb3 + bm_ * (int)SHM_V, pa0, pa1, pa2, pa3, ol, osel, pB0, pB1, negb2);
      FSM(pB0, pB1, alB); SBAR();
      pv_d0<FIXM>(o, vb3 + b0_ * (int)SHM_V, pa0, pa1, pa2, pa3, &ol, osel); }
#undef DMA3
#undef VMW0
  } else {
  SLOAD(SE, 0); asm volatile("s_waitcnt vmcnt(0)" ::: "memory"); SWRITE(0, SE); __syncthreads();
  qkt(pA0, pA1, K_lds, qr, r32, hi); hook(pA0, pA1, 0, wid, r32, hi); PSM(pA0, pA1, mnA, alA);
  SLOAD(SO, KVBLK); if constexpr (SDEPTH == 2) { if (2 < NT) SLOAD(SE, 2 * KVBLK); }
  SWAIT(); SWRITE(1, SO); __syncthreads();
  for (int j = 1; j + 1 < NT; j += 2) {
    SBAR(); qkt(pB0, pB1, (bf16*)((char*)K_lds + SHM_K), qr, r32, hi);
    FSM(pA0, pA1, alA); SBAR();
    if (!ODDNT || j + SDEPTH < NT) SLOAD(SO, (j + SDEPTH) * KVBLK); SBAR();
    pv_d0<FIXM>(o, vb0, pa0, pa1, pa2, pa3, &ol, osel); hook(pB0, pB1, j, wid, r32, hi); PSM(pB0, pB1, mnB, alB);
    __syncthreads(); SWAIT(); SWRITE(0, SE);
    RESCF(alB); __syncthreads();
    SBAR(); qkt(pA0, pA1, K_lds, qr, r32, hi);
    FSM(pB0, pB1, alB); SBAR();
    if (SDEPTH == 1 || j + 3 < NT) SLOAD(SE, (j + 1 + SDEPTH) * KVBLK); SBAR();
    pv_d0<FIXM>(o, vb0 + (int)SHM_V, pa0, pa1, pa2, pa3, &ol, osel); hook(pA0, pA1, j + 1, wid, r32, hi); PSM(pA0, pA1, mnA, alA);
    __syncthreads(); SWAIT(); SWRITE(1, SO);
    RESCF(alA); __syncthreads();
  }
  if constexpr (ODDNT) {
  FSM(pA0, pA1, alA); SBAR();
  pv_d0<FIXM>(o, vb0, pa0, pa1, pa2, pa3, &ol, osel);
  } else {
  SBAR(); qkt(pB0, pB1, (bf16*)((char*)K_lds + SHM_K), qr, r32, hi);
  FSM(pA0, pA1, alA); SBAR();
  pv_d0<FIXM>(o, vb0, pa0, pa1, pa2, pa3, &ol, osel); hook(pB0, pB1, NT - 1, wid, r32, hi); PSM(pB0, pB1, mnB, alB);
  __syncthreads(); RESCF(alB);
  FSM(pB0, pB1, alB); SBAR();
  pv_d0<FIXM>(o, vb0 + (int)SHM_V, pa0, pa1, pa2, pa3, &ol, osel);
  }
  }
  float rli[16];
  if constexpr (FIXM) { if ((lane & 7) == 0) { float* dst = li_l + 4 * (lane >> 4) + ((lane & 8) ? 16 : 0); dst[0] = ol[0]; dst[1] = ol[1]; dst[2] = ol[2]; dst[3] = ol[3]; } }
  else { if (hi == 0) li_l[r32] = l_reg; }
  asm volatile("s_waitcnt lgkmcnt(0)" ::: "memory");
#pragma unroll
  for (int r = 0; r < 16; ++r) rli[r] = __builtin_amdgcn_rcpf(li_l[crow(r, hi)]);
  bf16* Ow = Ob + (long)(wid * QBLK) * LDO;
  float sq[16];
#pragma unroll
  for (int r = 0; r < 16; ++r) { int orow = crow(r, hi); sq[r] = 0.f;
#pragma unroll
    for (int d0 = 0; d0 < 4; ++d0) { const float v = o[d0][r] * rli[r]; sq[r] += v * v; const unsigned u = __float_as_uint(v); Ow[(long)orow * LDO + d0 * 32 + r32] = (bf16)((u + 0x7fffu + ((u >> 16) & 1u)) >> 16); } }
  if (ssrow) {
    float s8[8], s4[4], s2[2], s1;
#pragma unroll
    for (int i = 0; i < 8; ++i) { const bool up = (r32 & 16) != 0; const float keep = up ? sq[i + 8] : sq[i], send = up ? sq[i] : sq[i + 8]; s8[i] = keep + __shfl_xor(send, 16); }
#pragma unroll
    for (int i = 0; i < 4; ++i) { const bool up = (r32 & 8) != 0; const float keep = up ? s8[i + 4] : s8[i], send = up ? s8[i] : s8[i + 4]; s4[i] = keep + __shfl_xor(send, 8); }
#pragma unroll
    for (int i = 0; i < 2; ++i) { const bool up = (r32 & 4) != 0; const float keep = up ? s4[i + 2] : s4[i], send = up ? s4[i] : s4[i + 2]; s2[i] = keep + __shfl_xor(send, 4); }
    { const bool up = (r32 & 2) != 0; const float keep = up ? s2[1] : s2[0], send = up ? s2[0] : s2[1]; s1 = keep + __shfl_xor(send, 2); }
    s1 += __shfl_xor(s1, 1);
    if ((r32 & 1) == 0) __hip_atomic_fetch_add(ssrow + wid * QBLK + crow(r32 >> 1, hi), (unsigned long long)(s1 * 1048576.0f + 0.5f), __ATOMIC_RELAXED, __HIP_MEMORY_SCOPE_AGENT);
  }
#undef SLOAD
#undef SWRITE
#undef SWAIT
#undef RESC
#undef RESCF
#undef PSM
#undef FSM
}
#undef KSWZ
#undef SBAR
}
constexpr int NWAVES = 8;
#ifndef ATT_SD
#define ATT_SD 1
#endif
#ifndef ATT_FIXM
#define ATT_FIXM true
#endif
#ifndef MK_PER_PHASE
#define MK_PER_PHASE 0
#endif

constexpr int S = 8192, DM = 4096, DFF = 11008, NL = 2;
constexpr int HD = 128, NHA = 16, NKVA = 4, NHB = 16, INC = 9216;
constexpr int C_QA = 0, C_KA = 2048, C_VA = 2560, C_QB = 3072, C_KB = 5120, C_VB = 7168;
constexpr int MEML = 256, NHM = 4, MEMW = 512;
constexpr float EPS = 1e-6f;
constexpr int NGU = 2 * DFF;
constexpr int PH_PER_LAYER = 11, NPH = 1 + PH_PER_LAYER * NL + 1;

constexpr size_t MiB = 1u << 20;
constexpr size_t WS_CTL = 0, CTL_ZERO_BYTES = 64 * 1024;
constexpr size_t SZ_GU = (size_t)NGU * DM * 2, SZ_D = (size_t)DM * DFF * 2, SZ_IN = (size_t)INC * DM * 2, SZ_OUT = (size_t)DM * DM * 2,
                 SZ_Q = (size_t)MEMW * DM * 2, SZ_KV = (size_t)2 * MEMW * DM * 2, SZ_O = (size_t)DM * MEMW * 2;
constexpr size_t LW_GU1 = 0, LW_D1 = LW_GU1 + SZ_GU, LW_IN = LW_D1 + SZ_D, LW_OUT = LW_IN + SZ_IN, LW_Q = LW_OUT + SZ_OUT, LW_KV = LW_Q + SZ_Q, LW_O = LW_KV + SZ_KV,
                 LW_GU2 = LW_O + SZ_O, LW_D2 = LW_GU2 + SZ_GU, LW_SIZE = LW_D2 + SZ_D;
constexpr size_t WS_W = 1 * MiB;
constexpr size_t WS_H = WS_W + NL * LW_SIZE;
constexpr size_t WS_ACT = WS_H + (size_t)S * DM * 2;
constexpr size_t WS_PROJ = WS_ACT + (size_t)S * DFF * 2;
constexpr size_t WS_OB = WS_PROJ + (size_t)S * INC * 2;
constexpr size_t WS_XO = WS_OB + (size_t)S * DM * 2;
constexpr size_t WS_MEMN = WS_XO + (size_t)S * MEMW * 2;
constexpr size_t WS_MKV = WS_MEMN + (size_t)NL * MEML * DM * 2;
constexpr size_t WS_SS = WS_MKV + (size_t)NL * MEML * NL * 2 * MEMW * 2;
constexpr size_t WS_WKV = WS_SS + (size_t)NL * 6 * S * 8;
constexpr size_t WS_XQP = WS_WKV + (size_t)NL * 2 * MEMW * DM * 2;
constexpr size_t WS_ROPE = WS_XQP + (size_t)4 * S * MEMW * 4;
constexpr size_t WS_END = WS_ROPE + 2 * 128 * 32 * 4;
static_assert(LW_SIZE % 256 == 0 && WS_H % 256 == 0 && WS_MKV % 256 == 0, "alignment");
constexpr int CW_BAR = 4096;

constexpr int RING_OFF = 0, RING_BYTES = 131072;
constexpr int TBL_OFF = 69632;
constexpr int LDSCTL_OFF = RING_BYTES, MISC_OFF = LDSCTL_OFF + 320, RS_OFF = LDSCTL_OFF + 1024;
constexpr int LDS_BYTES = 147456;
static_assert(att::SHM_ATTN <= TBL_OFF && TBL_OFF + 4096 <= RING_BYTES, "LDS map");

#define GAS __attribute__((address_space(1)))
#define LAS __attribute__((address_space(3)))
typedef unsigned short bf16;
typedef unsigned v4u __attribute__((ext_vector_type(4)));
typedef float f32x4 __attribute__((ext_vector_type(4)));
typedef short bf16x8 __attribute__((ext_vector_type(8)));
typedef GAS unsigned gu32;
typedef GAS unsigned long long gu64;
#define RLX_AGENT __ATOMIC_RELAXED, __HIP_MEMORY_SCOPE_AGENT
#define LDS_WAIT() asm volatile("s_waitcnt lgkmcnt(0)" ::: "memory")
#define VM_WAIT() asm volatile("s_waitcnt vmcnt(0)" ::: "memory")
__device__ __forceinline__ unsigned long long rt() { return __builtin_amdgcn_s_memrealtime(); }
__device__ __forceinline__ unsigned f2bf(float f) { unsigned u = __builtin_bit_cast(unsigned, f); return (u + 0x7fffu + ((u >> 16) & 1u)) >> 16; }
__device__ __forceinline__ unsigned pk2(float lo, float hi) { return f2bf(lo) | (f2bf(hi) << 16); }

#define XB_TMO      128
#define XB_XCNT(j)  (256  + 64 * (j))
#define XB_XSUB(j)  (1280 + 64 * (j))
#define XB_XGEN(j)  (2304 + 64 * (j))
#define XB_TOP      3328
#define XB_TOPGEN   3392
#define XCD_BAR_WORDS 3456
#define XB_SPIN_CAP (1u << 18)

__device__ __forceinline__ unsigned xb_ld(unsigned* p)              { return __hip_atomic_load(p, __ATOMIC_RELAXED, __HIP_MEMORY_SCOPE_AGENT); }
__device__ __forceinline__ unsigned xb_add(unsigned* p, unsigned v) { return __hip_atomic_fetch_add(p, v, __ATOMIC_RELAXED, __HIP_MEMORY_SCOPE_AGENT); }
__device__ __forceinline__ unsigned xb_xcc_id() { return (unsigned)__builtin_amdgcn_s_getreg((3 << 11) | 20) & 0xFu; }
#define XB_SPIN(cond, bar) do { unsigned _sp = 0; while (cond) { __builtin_amdgcn_s_sleep(1); \
    if ((++_sp & 255u) == 0u) { if (xb_ld(&(bar)[XB_TMO])) break; if (_sp > XB_SPIN_CAP) { atomicAdd(&(bar)[XB_TMO], 1u); break; } } } } while (0)

struct XcdBarrier {
    unsigned* bar; unsigned x;
    volatile LAS unsigned* st;
};

__device__ __forceinline__ XcdBarrier xcd_barrier_post(unsigned* bar, volatile LAS unsigned* st) {
    XcdBarrier b; b.bar = bar; b.x = xb_xcc_id(); b.st = st;
    if (threadIdx.x == 0) (void)xb_add(&bar[XB_XCNT(b.x)], 1u);
    return b;
}
__device__ __forceinline__ void xcd_barrier_complete(unsigned* bar, unsigned x, unsigned& nloc, unsigned& nx) {
    const unsigned G = gridDim.x * gridDim.y * gridDim.z;
    unsigned sum, cnt, mine, sp = 0u;
    for (;;) {
        sum = 0u; cnt = 0u; mine = 0u;
#pragma unroll
        for (unsigned j = 0; j < 16; ++j) { const unsigned c = xb_ld(&bar[XB_XCNT(j)]); sum += c; cnt += (c > 0u) ? 1u : 0u; mine = (j == x) ? c : mine; }
        if (sum == G) break;
        __builtin_amdgcn_s_sleep(1);
        if ((++sp & 255u) == 0u) { if (xb_ld(&bar[XB_TMO])) break; if (sp > XB_SPIN_CAP) { atomicAdd(&bar[XB_TMO], 1u); break; } }
    }
    nloc = mine > 0u ? mine : 1u; nx = cnt > 0u ? cnt : 1u;
}

__device__ __forceinline__ void xcd_barrier(const XcdBarrier& b) {
    asm volatile("s_waitcnt vmcnt(0)" ::: "memory");
    __syncthreads();
    if (threadIdx.x == 0) {
        unsigned* bar = b.bar;
        __builtin_amdgcn_s_waitcnt(0);
        unsigned nloc = b.st[0], nx = b.st[1];
        if (nloc == 0u) { xcd_barrier_complete(bar, b.x, nloc, nx); b.st[0] = nloc; b.st[1] = nx; }
        const unsigned old = xb_add(&bar[XB_XSUB(b.x)], 1u);
        const unsigned gen = old / nloc;
        if (old + 1u == (gen + 1u) * nloc) {
            __builtin_amdgcn_fence(__ATOMIC_RELEASE, "agent");
            asm volatile("s_waitcnt vmcnt(0)" ::: "memory");
            const unsigned og = xb_add(&bar[XB_TOP], 1u);
            const unsigned tg = og / nx;
            if (og + 1u == (tg + 1u) * nx) xb_add(&bar[XB_TOPGEN], 1u);
            else XB_SPIN(xb_ld(&bar[XB_TOPGEN]) == tg, bar);
            __builtin_amdgcn_fence(__ATOMIC_ACQUIRE, "agent");
            xb_add(&bar[XB_XGEN(b.x)], 1u);
            asm volatile("s_waitcnt vmcnt(0)" ::: "memory");
        } else {
            XB_SPIN(xb_ld(&bar[XB_XGEN(b.x)]) == gen, bar);
            __builtin_amdgcn_fence(__ATOMIC_ACQUIRE, "agent");
            asm volatile("s_waitcnt vmcnt(0)" ::: "memory");
        }
    }
    __syncthreads();
}

struct Frame {
    LAS unsigned char* lds;
    volatile LAS unsigned* MISC;
    gu32* ctl;
    int vcu, G;
};
__device__ __forceinline__ float wave_sum(float v) {
#pragma unroll
    for (int o = 1; o < 64; o <<= 1) v += __shfl_xor(v, o);
    return v;
}
__device__ __forceinline__ void transpose_item(const float* W, int K, int N, bf16* WT, int kb, int n0, int drow0, const float* gk, LAS float* scr, int lane) {
    const int k0 = 64 * kb;
    const float gl = gk ? gk[k0 + lane] : 1.0f;
#pragma unroll 8
    for (int i = 0; i < 32; ++i) { const int kk = 2 * i + (lane >> 5); scr[kk * 33 + (lane & 31)] = __builtin_nontemporal_load(W + (size_t)(k0 + kk) * N + n0 + (lane & 31)) * __shfl(gl, kk); }
    LDS_WAIT(); asm volatile("" ::: "memory");
    const int c = lane & 7;
#pragma unroll
    for (int j = 0; j < 4; ++j) { const int n = (lane >> 3) + 8 * j; const LAS float* s = scr + (8 * c) * 33 + n;
        v4u o; o.x = pk2(s[0 * 33], s[1 * 33]); o.y = pk2(s[2 * 33], s[3 * 33]); o.z = pk2(s[4 * 33], s[5 * 33]); o.w = pk2(s[6 * 33], s[7 * 33]);
        *(GAS v4u*)(WT + (size_t)(drow0 + n) * K + k0 + 8 * c) = o; }
    LDS_WAIT(); asm volatile("" ::: "memory");
}
constexpr int I_G = (DM / 64) * (DFF / 32), I_D = (DFF / 64) * (DM / 32), I_IN = (DM / 64) * (INC / 32), I_OUT = (DM / 64) * (DM / 32),
              I_Q = (DM / 64) * (MEMW / 32), I_KV = (DM / 64) * (2 * MEMW / 32), I_O = (MEMW / 64) * (DM / 32);
constexpr int ITEMS_LAYER = 6 * I_G + I_IN + I_OUT + I_Q + I_KV + I_O;
static_assert(I_G == I_D, "gate/up/down item counts");

struct Args { const float* in[24]; float* out; unsigned char* ws; int ph_lo, ph_hi; };

__device__ __forceinline__ void p0_prologue(Frame& F, const Args& args) {
    const int tid_ = opaque_tid(), lane_ = tid_ & 63, wave_ = __builtin_amdgcn_readfirstlane(tid_ >> 6); (void)tid_; (void)lane_; (void)wave_;
    LAS float* scr = (LAS float*)(F.lds + RING_OFF + wave_ * 16384);
    const int gw = F.vcu * NWAVES + wave_, NGW = F.G * NWAVES;
    for (int it = gw; it < NL * ITEMS_LAYER; it += NGW) {
        const int l = it / ITEMS_LAYER; int r = it - l * ITEMS_LAYER;
        unsigned char* wl = args.ws + WS_W + (size_t)l * LW_SIZE;
        const float* W; int K, N; bf16* WT; int mode = 0; const float* gk = nullptr;
        if (r < I_G) { W = args.in[3] + (size_t)l * DM * DFF; K = DM; N = DFF; WT = (bf16*)(wl + LW_GU1); mode = 1; gk = args.in[2] + (size_t)l * DM; }
        else if ((r -= I_G) < I_G) { W = args.in[4] + (size_t)l * DM * DFF; K = DM; N = DFF; WT = (bf16*)(wl + LW_GU1); mode = 2; gk = args.in[2] + (size_t)l * DM; }
        else if ((r -= I_G) < I_D) { W = args.in[5] + (size_t)l * DFF * DM; K = DFF; N = DM; WT = (bf16*)(wl + LW_D1); }
        else if ((r -= I_D) < I_IN) { W = args.in[7] + (size_t)l * DM * INC; K = DM; N = INC; WT = (bf16*)(wl + LW_IN); gk = args.in[6] + (size_t)l * DM; }
        else if ((r -= I_IN) < I_OUT) { W = args.in[13] + (size_t)l * DM * DM; K = DM; N = DM; WT = (bf16*)(wl + LW_OUT); mode = 3; }
        else if ((r -= I_OUT) < I_Q) { W = args.in[16] + (size_t)l * DM * MEMW; K = DM; N = MEMW; WT = (bf16*)(wl + LW_Q); gk = args.in[14] + (size_t)l * DM; }
        else if ((r -= I_Q) < I_KV) { W = args.in[17] + (size_t)l * DM * 2 * MEMW; K = DM; N = 2 * MEMW; WT = (bf16*)(args.ws + WS_WKV) + (size_t)l * 2 * MEMW * DM; }
        else if ((r -= I_KV) < I_O) { W = args.in[18] + (size_t)l * MEMW * DM; K = MEMW; N = DM; WT = (bf16*)(wl + LW_O); }
        else if ((r -= I_O) < I_G) { W = args.in[20] + (size_t)l * DM * DFF; K = DM; N = DFF; WT = (bf16*)(wl + LW_GU2); mode = 1; gk = args.in[19] + (size_t)l * DM; }
        else if ((r -= I_G) < I_G) { W = args.in[21] + (size_t)l * DM * DFF; K = DM; N = DFF; WT = (bf16*)(wl + LW_GU2); mode = 2; gk = args.in[19] + (size_t)l * DM; }
        else { r -= I_G; W = args.in[22] + (size_t)l * DFF * DM; K = DFF; N = DM; WT = (bf16*)(wl + LW_D2); }
        const int kblk = K / 64, kb = r % kblk, n0 = 32 * (r / kblk);
        const int drow0 = (mode == 0 || mode == 3) ? n0 : (256 * (n0 >> 7) + (n0 & 127) + (mode == 2 ? 128 : 0));
        if (mode == 3) gk = (kb < 32) ? args.in[11] + (size_t)l * 2048 : args.in[12] + (size_t)l * 2048 - 2048;
        transpose_item(W, K, N, WT, kb, n0, drow0, gk, scr, lane_);
    }
}
__device__ __forceinline__ void rms_rows_bf16(Frame& F, const float* X, const float* g, bf16* H, int nrows) {
    const int tid_ = opaque_tid(), lane_ = tid_ & 63, wave_ = __builtin_amdgcn_readfirstlane(tid_ >> 6); (void)tid_; (void)lane_; (void)wave_;
    const int gw = F.vcu * NWAVES + wave_, NGW = F.G * NWAVES;
    f32x4 gv[16];
#pragma unroll
    for (int j = 0; j < 16; ++j) gv[j] = ((const GAS f32x4*)g)[64 * j + lane_];
    for (int m = gw; m < nrows; m += NGW) {
        const GAS f32x4* xr = (const GAS f32x4*)(X + (size_t)m * DM) + lane_;
        f32x4 v[16]; float s = 0.f;
#pragma unroll
        for (int j = 0; j < 16; ++j) { v[j] = xr[64 * j]; s += (v[j].x * v[j].x + v[j].y * v[j].y) + (v[j].z * v[j].z + v[j].w * v[j].w); }
        const float rstd = 1.f / sqrtf(wave_sum(s) * (1.f / DM) + EPS);
        GAS unsigned long long* o8 = (GAS unsigned long long*)(H + (size_t)m * DM) + lane_;
#pragma unroll
        for (int j = 0; j < 16; ++j) { const f32x4 y = v[j] * rstd * gv[j]; o8[64 * j] = (unsigned long long)pk2(y.x, y.y) | ((unsigned long long)pk2(y.z, y.w) << 32); }
    }
}
__device__ __forceinline__ void xb_rows(Frame& F, const float* X, bf16* XB, unsigned long long* ss) {
    const int tid_ = opaque_tid(), lane_ = tid_ & 63, wave_ = __builtin_amdgcn_readfirstlane(tid_ >> 6);
    const int gw = F.vcu * NWAVES + wave_, NGW = F.G * NWAVES;
    for (int m = gw; m < S; m += NGW) {
        const GAS f32x4* xr = (const GAS f32x4*)(X + (size_t)m * DM) + lane_;
        f32x4 v[16]; float s = 0.f;
#pragma unroll
        for (int j = 0; j < 16; ++j) { v[j] = xr[64 * j]; s += (v[j].x * v[j].x + v[j].y * v[j].y) + (v[j].z * v[j].z + v[j].w * v[j].w); }
        s = wave_sum(s);
        if (lane_ == 0) ss[m] = (unsigned long long)(s * pg8::SS_FIX + 0.5f);
        GAS unsigned long long* o8 = (GAS unsigned long long*)(XB + (size_t)m * DM) + lane_;
#pragma unroll
        for (int j = 0; j < 16; ++j) o8[64 * j] = (unsigned long long)pk2(v[j].x, v[j].y) | ((unsigned long long)pk2(v[j].z, v[j].w) << 32);
    }
}
__device__ __forceinline__ void final_rows_f32(Frame& F, const bf16* XB, const float* g, float* O, int nrows, bool poison) {
    const int tid_ = opaque_tid(), lane_ = tid_ & 63, wave_ = __builtin_amdgcn_readfirstlane(tid_ >> 6);
    const int gw = F.vcu * NWAVES + wave_, NGW = F.G * NWAVES;
    for (int m = gw; m < nrows; m += NGW) {
        const GAS v4u* p = (const GAS v4u*)(XB + (size_t)m * DM) + lane_;
        v4u w[8]; float s = 0.f;
#pragma unroll
        for (int j = 0; j < 8; ++j) { w[j] = p[64 * j];
#pragma unroll
            for (int e = 0; e < 4; ++e) { const float lo = __uint_as_float(w[j][e] << 16), hi = __uint_as_float(w[j][e] & 0xffff0000u); s += lo * lo + hi * hi; } }
        float rstd = 1.f / sqrtf(wave_sum(s) * (1.f / DM) + EPS);
        if (poison) rstd = __builtin_nanf("");
#pragma unroll
        for (int j = 0; j < 8; ++j) { const float* gp = g + 512 * j + 8 * lane_; const f32x4 g0 = *(const GAS f32x4*)gp, g1 = *(const GAS f32x4*)(gp + 4);
            f32x4 o0, o1;
            o0[0] = __uint_as_float(w[j][0] << 16) * rstd * g0[0]; o0[1] = __uint_as_float(w[j][0] & 0xffff0000u) * rstd * g0[1]; o0[2] = __uint_as_float(w[j][1] << 16) * rstd * g0[2]; o0[3] = __uint_as_float(w[j][1] & 0xffff0000u) * rstd * g0[3];
            o1[0] = __uint_as_float(w[j][2] << 16) * rstd * g1[0]; o1[1] = __uint_as_float(w[j][2] & 0xffff0000u) * rstd * g1[1]; o1[2] = __uint_as_float(w[j][3] << 16) * rstd * g1[2]; o1[3] = __uint_as_float(w[j][3] & 0xffff0000u) * rstd * g1[3];
            GAS f32x4* op = (GAS f32x4*)(O + (size_t)m * DM + 512 * j + 8 * lane_); op[0] = o0; op[1] = o1; }
    }
}
constexpr float QPRE = ATT_PRESCALED ? att::SCALE * 1.4426950408889634f : 1.0f;
__device__ __forceinline__ void qk_prep(Frame& F, bf16* PROJ, const float* qg, const float* kg, const float* rope) {
    const int tid_ = opaque_tid(), lane_ = tid_ & 63, wave_ = __builtin_amdgcn_readfirstlane(tid_ >> 6); (void)tid_; (void)lane_; (void)wave_;
    LAS float* tab = (LAS float*)(F.lds + RING_OFF);
    for (int idx = tid_; idx < 2 * 128 * 32; idx += NWAVES * 64) tab[idx] = rope[idx];
    __syncthreads();
    const int gw = F.vcu * NWAVES + wave_, NGW = F.G * NWAVES;
    const int hsub = lane_ >> 4, axis = (lane_ >> 3) & 1, jp = lane_ & 7, eo = axis * 64 + 4 * jp;
    const f32x4 q1 = *(const GAS f32x4*)(qg + eo), q2 = *(const GAS f32x4*)(qg + eo + 32), k1 = *(const GAS f32x4*)(kg + eo), k2 = *(const GAS f32x4*)(kg + eo + 32);
    for (int it0 = gw; it0 < S * 5; it0 += 4 * NGW) {
        unsigned long long w1[4], w2[4];
#pragma unroll
        for (int j = 0; j < 4; ++j) { const int it = it0 + j * NGW; if (it < S * 5) { const int t = it / 5, grp = it - 5 * t, hh = grp * 4 + hsub;
            const GAS unsigned long long* p = (const GAS unsigned long long*)(PROJ + (size_t)t * INC + hh * HD + eo); w1[j] = p[0]; w2[j] = p[8]; } else { w1[j] = 0ull; w2[j] = 0ull; } }
#pragma unroll
        for (int j = 0; j < 4; ++j) { const int it = it0 + j * NGW; if (it >= S * 5) break;
            const int t = it / 5, grp = it - 5 * t, hh = grp * 4 + hsub;
            GAS unsigned long long* p = (GAS unsigned long long*)(PROJ + (size_t)t * INC + hh * HD + eo);
            float x1[4], x2[4];
            x1[0] = __uint_as_float((unsigned)w1[j] << 16); x1[1] = __uint_as_float((unsigned)w1[j] & 0xffff0000u); x1[2] = __uint_as_float((unsigned)(w1[j] >> 32) << 16); x1[3] = __uint_as_float((unsigned)(w1[j] >> 32) & 0xffff0000u);
            x2[0] = __uint_as_float((unsigned)w2[j] << 16); x2[1] = __uint_as_float((unsigned)w2[j] & 0xffff0000u); x2[2] = __uint_as_float((unsigned)(w2[j] >> 32) << 16); x2[3] = __uint_as_float((unsigned)(w2[j] >> 32) & 0xffff0000u);
            float ss = 0.f;
#pragma unroll
            for (int e = 0; e < 4; ++e) ss += x1[e] * x1[e] + x2[e] * x2[e];
            ss += __shfl_xor(ss, 1); ss += __shfl_xor(ss, 2); ss += __shfl_xor(ss, 4); ss += __shfl_xor(ss, 8);
            const float rstd = 1.f / sqrtf(ss * (1.f / HD) + EPS);
            const f32x4 g1 = grp < 4 ? q1 : k1, g2 = grp < 4 ? q2 : k2;
            const int pos = axis ? (t & 63) : (t >> 6);
            const LAS float* tc = tab + pos * 32 + 4 * jp;
            float o1[4], o2[4];
            const float qs = grp < 4 ? QPRE : 1.0f;
#pragma unroll
            for (int e = 0; e < 4; ++e) { const float y1 = x1[e] * rstd * g1[e] * qs, y2 = x2[e] * rstd * g2[e] * qs, c = tc[e], s = tc[4096 + e]; o1[e] = y1 * c - y2 * s; o2[e] = y2 * c + y1 * s; }
            p[0] = (unsigned long long)pk2(o1[0], o1[1]) | ((unsigned long long)pk2(o1[2], o1[3]) << 32);
            p[8] = (unsigned long long)pk2(o2[0], o2[1]) | ((unsigned long long)pk2(o2[2], o2[3]) << 32);
        }
    }
}
struct PartQ {
    const float* base; const unsigned long long* ss;
    __device__ __forceinline__ att::bf16x8 operator()(int r, int d) const {
        const float rs = pg8::rstd_of(ss, r); const float* p = base + (size_t)r * MEMW + d; f32x4 a = {0.f, 0.f, 0.f, 0.f}, b = {0.f, 0.f, 0.f, 0.f};
#pragma unroll
        for (int ks = 0; ks < 4; ++ks) { a += *(const f32x4*)(p + (size_t)ks * S * MEMW); b += *(const f32x4*)(p + (size_t)ks * S * MEMW + 4); }
        a *= rs; b *= rs;
        att::u32x4 w = {att::cvtpk(a[0], a[1]), att::cvtpk(a[2], a[3]), att::cvtpk(b[0], b[1]), att::cvtpk(b[2], b[3])}; return *reinterpret_cast<att::bf16x8*>(&w); }
};
struct NattenHook {
    const LAS float* tbl; int i0, kr0;
    __device__ __forceinline__ bool active(int tile, int w) const { const int i = i0 + (w >> 1), rs = min(max(i - 4, 0), 120); return (unsigned)(kr0 + tile - rs) < 8u; }
    __device__ __forceinline__ void operator()(att::f32x16& p0, att::f32x16& p1, int tile, int, int, int) const {
        const int t_ = opaque_tid(), wid = t_ >> 6, r32 = t_ & 31, hi = (t_ >> 5) & 1;
        const int i = i0 + (wid >> 1), cq = (wid & 1) * 32 + r32;
        const int rs = min(max(i - 4, 0), 120), cs = min(max(cq - 8, 0), 48), kr = kr0 + tile;
        const float NEG = -__builtin_inff();
        if ((unsigned)(kr - rs) >= 8u) {
#pragma unroll
            for (int r = 0; r < 16; ++r) { p0[r] = NEG; p1[r] = NEG; }
            return; }
        const LAS float* tp = tbl + ((kr - i + 7) * 31 + 15 - cq + 4 * hi);
        const int d0 = 4 * hi - cs;
#pragma unroll
        for (int g = 0; g < 4; ++g) {
            float bb[8];
#pragma unroll
            for (int q = 0; q < 4; ++q) { const int kcc = q + 8 * g; bb[2 * q] = tp[kcc]; bb[2 * q + 1] = tp[kcc + 32]; }
            asm volatile("" : "+v"(bb[0]), "+v"(bb[1]), "+v"(bb[2]), "+v"(bb[3]), "+v"(bb[4]), "+v"(bb[5]), "+v"(bb[6]), "+v"(bb[7]));
#pragma unroll
            for (int q = 0; q < 4; ++q) { const int r = 4 * g + q, kcc = q + 8 * g;
                const float s0 = p0[r] + bb[2 * q], s1 = p1[r] + bb[2 * q + 1];
                p0[r] = ((unsigned)(kcc + d0) < 16u) ? s0 : NEG; p1[r] = ((unsigned)(kcc + 32 + d0) < 16u) ? s1 : NEG; }
        }
    }
};

__device__ __forceinline__ int rs_fill(Frame& F, const pg8::StaticOrder& So, const unsigned long long* ss) {
    pg8::Unit u0; int pm0 = -1;
    if (So.next(0, u0)) { pm0 = u0.pm; const int t = opaque_tid(); if (t < 256) ((LAS float*)(F.lds + RS_OFF))[t] = pg8::rstd_of(ss, pm0 * 256 + t); }
    __syncthreads();
    return pm0;
}

__device__ __forceinline__ int rs_fill2(Frame& F, const pg8::StaticOrder& So, const unsigned long long* ssa, const unsigned long long* ssb) {
    pg8::Unit u0; int pm0 = -1;
    if (So.next(0, u0)) { pm0 = u0.pm; const int t = opaque_tid(); if (t < 256) { const float ra = pg8::rstd2k_of(ssa, pm0 * 256 + t), rb = pg8::rstd2k_of(ssb, pm0 * 256 + t);
        LAS float* tb = (LAS float*)(F.lds + RS_OFF); tb[t] = ra / rb; tb[256 + t] = rb; } }
    __syncthreads();
    return pm0;
}

__global__ void __launch_bounds__(NWAVES * 64, 2) mega_fwd(Args args) {
    extern __shared__ __attribute__((aligned(16))) unsigned char lds[];
    Frame F;
    F.lds = (LAS unsigned char*)lds;
    F.MISC = (volatile LAS unsigned*)(F.lds + MISC_OFF);
    F.G = gridDim.x; { const int bx = blockIdx.x; F.vcu = (F.G % 8 == 0) ? (bx % 8) * (F.G / 8) + bx / 8 : bx; }
    unsigned char* ws = args.ws;
    F.ctl = (gu32*)(ws + WS_CTL);
    for (int u = threadIdx.x; u < (LDS_BYTES - LDSCTL_OFF) / 4; u += NWAVES * 64) ((LAS unsigned*)(F.lds + LDSCTL_OFF))[u] = 0u;
    __syncthreads();
    XcdBarrier bar; bar.bar = (unsigned*)(F.ctl + CW_BAR); bar.x = 0; bar.st = nullptr;
    if (!MK_PER_PHASE) bar = xcd_barrier_post((unsigned*)(F.ctl + CW_BAR), F.MISC + 8);
#define GRID_BAR() do { if (MK_PER_PHASE) { if (threadIdx.x == 0) __hip_atomic_store(F.ctl + 0, 0xBADBA0u, RLX_AGENT); } else { xcd_barrier(bar); } } while (0)
    const int lo = args.ph_lo, hi = args.ph_hi;
#define IN(k) (lo <= (k) && (k) < hi)
#define SEAM(k) do { if (IN(k) && IN((k) + 1)) GRID_BAR(); } while (0)

    bf16* XB = (bf16*)(ws + WS_H); bf16* ACT = (bf16*)(ws + WS_ACT); bf16* PROJ = (bf16*)(ws + WS_PROJ); bf16* OB = (bf16*)(ws + WS_OB);
    float* XQP = (float*)(ws + WS_XQP); float* ROPE = (float*)(ws + WS_ROPE); bf16* XO = (bf16*)(ws + WS_XO); bf16* MEMN = (bf16*)(ws + WS_MEMN); bf16* MKV = (bf16*)(ws + WS_MKV);
    unsigned long long* SSQ = (unsigned long long*)(ws + WS_SS);
#define SS_OF(l_, k_) (SSQ + ((size_t)(l_) * 6 + (k_)) * S)

    if (IN(0)) {
        p0_prologue(F, args);
        xb_rows(F, args.in[0], XB, SS_OF(0, 0));
        for (int l = 0; l < NL; ++l) rms_rows_bf16(F, args.in[1], args.in[15] + (size_t)l * DM, MEMN + (size_t)l * MEML * DM, MEML);
        for (size_t i = (size_t)blockIdx.x * (NWAVES * 64) + opaque_tid(); i < (size_t)(NL * 6 - 1) * S; i += (size_t)F.G * NWAVES * 64) SSQ[S + i] = 0ull;
        for (int idx = (int)blockIdx.x * (NWAVES * 64) + opaque_tid(); idx < 128 * 32; idx += F.G * NWAVES * 64) { const int pos = idx >> 5, f = idx & 31;
            const float invf = powf(10000.f, -(float)f * (1.f / 32.f)); float sn, cs; sincosf((float)pos * invf, &sn, &cs); ROPE[idx] = cs; ROPE[4096 + idx] = sn; }
    }
    SEAM(0);

    for (int l = 0; l < NL; ++l) {
        const int pb = 1 + PH_PER_LAYER * l;
        unsigned char* wl = ws + WS_W + (size_t)l * LW_SIZE;
        const bool lastl = (l == NL - 1);

        if (IN(pb + 0)) { pg8::Gemm g{XB, (const bf16*)(wl + LW_GU1), S, NGU, DM, DM}; pg8::StaticOrder So; So.init(S, NGU, F.G, opaque_bid());
            const int rpm = rs_fill(F, So, SS_OF(l, 0)); pg8::EpiSwiglu E{ACT, DFF, SS_OF(l, 0), (const LAS float*)(F.lds + RS_OFF), rpm}; pg8::gemm_phase<pg8::EpiSwiglu, pg8::StaticOrder, true, true>(F.lds + RING_OFF, g, So, E);
            if (l == 0) {
                pg8::Gemm g2{MEMN, (const bf16*)(ws + WS_WKV), NL * MEML, NL * 2 * MEMW, DM, DM}; pg8::KvOrder Ko{(opaque_bid() + 64) % F.G};
                pg8::EpiBf16 E2{MKV, NL * 2 * MEMW, nullptr, nullptr, -1}; pg8::gemm_phase<pg8::EpiBf16, pg8::KvOrder, true, true>(F.lds + RING_OFF, g2, Ko, E2); } }
        SEAM(pb + 0);
        if (IN(pb + 1)) { pg8::Gemm g{ACT, (const bf16*)(wl + LW_D1), S, DM, DFF, DFF}; pg8::StaticOrder So; So.init(S, DM, F.G, opaque_bid());
            pg8::EpiResidBf E{XB, DM, 0.5f, SS_OF(l, 1)}; pg8::gemm_phase<pg8::EpiResidBf, pg8::StaticOrder, true, true>(F.lds + RING_OFF, g, So, E); }
        SEAM(pb + 1);
        if (IN(pb + 2)) { pg8::Gemm g{XB, (const bf16*)(wl + LW_IN), S, INC, DM, DM}; pg8::StaticOrder So; So.init(S, INC, F.G, opaque_bid());
            const int rpm = rs_fill(F, So, SS_OF(l, 1)); pg8::EpiBf16 E{PROJ, INC, SS_OF(l, 1), (const LAS float*)(F.lds + RS_OFF), rpm}; pg8::gemm_phase<pg8::EpiBf16, pg8::StaticOrder, true, true>(F.lds + RING_OFF, g, So, E); }
        SEAM(pb + 2);
        if (IN(pb + 3)) { qk_prep(F, PROJ, args.in[8] + (size_t)l * HD, args.in[9] + (size_t)l * HD, ROPE); __syncthreads(); }
        SEAM(pb + 3);
        if (IN(pb + 4)) {
            float negb2; { const int ln = opaque_tid() & 63; const float* gq = args.in[8] + (size_t)l * HD; const float* gk_ = args.in[9] + (size_t)l * HD;
                float mq = fmaxf(fabsf(gq[ln]), fabsf(gq[ln + 64])), mk = fmaxf(fabsf(gk_[ln]), fabsf(gk_[ln + 64]));
#pragma unroll
                for (int o_ = 1; o_ < 64; o_ <<= 1) { mq = fmaxf(mq, __shfl_xor(mq, o_)); mk = fmaxf(mk, __shfl_xor(mk, o_)); }
                float nb = -(11.313708499f * mq * mk * 1.03f) * 1.4426950408889634f; if (ATT_PRESCALED && nb > -60.f) nb = 0.f;
                negb2 = __builtin_bit_cast(float, __builtin_amdgcn_readfirstlane(__builtin_bit_cast(int, nb))); }
            for (int u = F.vcu; u < NHA * (S / 256); u += F.G) { const int h = u >> 5, qb = u & 31, kvh = h >> 2;
                att::attn_dense_body<INC, DM, ATT_SD, ATT_FIXM, att::BfQ, att::NoHook>(att::BfQ{PROJ + (size_t)qb * 256 * INC + C_QA + h * HD, INC}, PROJ + C_KA + kvh * HD, PROJ + C_VA + kvh * HD,
                                                                OB + (size_t)qb * 256 * DM + h * HD, S, (char*)lds + RING_OFF, att::NoHook{}, SS_OF(l, 4) + qb * 256, negb2);
                __syncthreads(); }
            for (int u = F.vcu; u < NHB * (S / 256); u += F.G) { const int h = u >> 5, blk = u & 31, i0 = 4 * blk, kr0 = min(max(i0 - 4, 0), 117);
                LAS float* tbl = (LAS float*)(F.lds + TBL_OFF + 256); const float* rp = args.in[10] + ((size_t)l * NHB + h) * 15 * 31;
                for (int i = opaque_tid(); i < 15 * 31; i += NWAVES * 64) tbl[i] = rp[i] * (1.0f / att::SCALE);
                __syncthreads();
                NattenHook hk{tbl, i0, kr0};
                att::attn_dense_body<INC, DM, 2, false, att::BfQ, NattenHook, true>(att::BfQ{PROJ + (size_t)blk * 256 * INC + C_QB + h * HD, INC}, PROJ + (size_t)kr0 * 64 * INC + C_KB + h * HD, PROJ + (size_t)kr0 * 64 * INC + C_VB + h * HD,
                                                               OB + (size_t)blk * 256 * DM + 2048 + h * HD, 704, (char*)lds + RING_OFF, hk, SS_OF(l, 5) + blk * 256);
                __syncthreads(); }
        }
        SEAM(pb + 4);
        if (IN(pb + 5)) { pg8::Gemm g{OB, (const bf16*)(wl + LW_OUT), S, DM, DM, DM}; pg8::StaticOrder So; So.init(S, DM, F.G, opaque_bid());
            const int tpm = rs_fill2(F, So, SS_OF(l, 4), SS_OF(l, 5));
            pg8::EpiResidMid E{XB, DM, SS_OF(l, 2), (const LAS float*)(F.lds + RS_OFF), tpm, SS_OF(l, 4), SS_OF(l, 5)}; pg8::gemm_phase<pg8::EpiResidMid, pg8::StaticOrder, true, true>(F.lds + RING_OFF, g, So, E); }
        SEAM(pb + 5);
        if (IN(pb + 6)) { pg8::Gemm g{XB, (const bf16*)(wl + LW_Q), S, MEMW, DM / 4, DM}; pg8::SplitK4Order So{F.vcu, F.G};
            pg8::EpiF32Part E{XQP, MEMW, (size_t)S * MEMW}; pg8::gemm_phase<pg8::EpiF32Part, pg8::SplitK4Order, true, true>(F.lds + RING_OFF, g, So, E); }
        SEAM(pb + 6);
        if (IN(pb + 7)) {
            for (int u = F.vcu; u < NHM * (S / 256); u += F.G) { const int h = u >> 5, qb = u & 31;
                PartQ ql{XQP + (size_t)qb * 256 * MEMW + h * HD, SS_OF(l, 2) + qb * 256};
                att::attn_dense_body<NL * 2 * MEMW, MEMW, 1, false, PartQ, att::NoHook>(ql, MKV + (size_t)l * MEML * (NL * 2 * MEMW) + l * 2 * MEMW + h * HD, MKV + (size_t)l * MEML * (NL * 2 * MEMW) + l * 2 * MEMW + MEMW + h * HD,
                                                                        XO + (size_t)qb * 256 * MEMW + h * HD, MEML, (char*)lds + RING_OFF, att::NoHook{});
                __syncthreads(); }
        }
        SEAM(pb + 7);
        if (IN(pb + 8)) { pg8::Gemm g{XO, (const bf16*)(wl + LW_O), S, DM, MEMW, MEMW}; pg8::StaticOrder So; So.init(S, DM, F.G, opaque_bid());
            pg8::EpiResidBf E{XB, DM, 1.0f, SS_OF(l, 3)}; pg8::gemm_phase<pg8::EpiResidBf, pg8::StaticOrder, true, true>(F.lds + RING_OFF, g, So, E); }
        SEAM(pb + 8);
        if (IN(pb + 9)) { pg8::Gemm g{XB, (const bf16*)(wl + LW_GU2), S, NGU, DM, DM}; pg8::StaticOrder So; So.init(S, NGU, F.G, opaque_bid());
            const int rpm = rs_fill(F, So, SS_OF(l, 3)); pg8::EpiSwiglu E{ACT, DFF, SS_OF(l, 3), (const LAS float*)(F.lds + RS_OFF), rpm}; pg8::gemm_phase<pg8::EpiSwiglu, pg8::StaticOrder, true, true>(F.lds + RING_OFF, g, So, E); }
        SEAM(pb + 9);
        if (IN(pb + 10)) { pg8::Gemm g{ACT, (const bf16*)(wl + LW_D2), S, DM, DFF, DFF}; pg8::StaticOrder So; So.init(S, DM, F.G, opaque_bid());
            pg8::EpiResidBf E{XB, DM, 0.5f, lastl ? nullptr : SS_OF(lastl ? 0 : l + 1, 0)};
            pg8::gemm_phase<pg8::EpiResidBf, pg8::StaticOrder, true, true>(F.lds + RING_OFF, g, So, E); }
        SEAM(pb + 10);
    }
    if (IN(NPH - 1)) {
        bool poison = false;
        if (!MK_PER_PHASE) poison = __hip_atomic_load((gu32*)((unsigned*)(F.ctl + CW_BAR) + XB_TMO), RLX_AGENT) != 0u;
        final_rows_f32(F, XB, args.in[23], args.out, S, poison);
    }
#undef IN
#undef SEAM
#undef GRID_BAR
}

extern "C" void kernel_launch(void* const* d_in, const int* in_sizes, int n_in, void* d_out, int out_size, void* d_ws, size_t ws_size, hipStream_t stream) {
    static int grid = 0;
    if (grid == 0) {
        if (n_in != 24 || in_sizes[0] != S * DM || out_size != S * DM || ws_size < WS_END) { fprintf(stderr, "kernel_launch: shape mismatch: n_in %d in0 %d out %d ws %zu (need %zu)\n", n_in, n_in > 0 ? in_sizes[0] : -1, out_size, ws_size, (size_t)WS_END); grid = -1; return; }
        int dev = 0, cus = 0, per_cu = 0;
        if (hipGetDevice(&dev) != hipSuccess || hipDeviceGetAttribute(&cus, hipDeviceAttributeMultiprocessorCount, dev) != hipSuccess) { grid = -1; return; }
        if (hipFuncSetAttribute((const void*)mega_fwd, hipFuncAttributeMaxDynamicSharedMemorySize, LDS_BYTES) != hipSuccess) { fprintf(stderr, "kernel_launch: hipFuncSetAttribute failed\n"); grid = -1; return; }
        if (hipOccupancyMaxActiveBlocksPerMultiprocessor(&per_cu, (const void*)mega_fwd, NWAVES * 64, LDS_BYTES) != hipSuccess || per_cu < 1)
            fprintf(stderr, "kernel_launch: note: occupancy query reports %d workgroups per CU\n", per_cu);
        (void)hipGetLastError();
        grid = cus;
    }
    if (grid < 0) return;
    if (hipMemsetAsync((char*)d_ws + WS_CTL, 0, CTL_ZERO_BYTES, stream) != hipSuccess) { fprintf(stderr, "kernel_launch: memset failed\n"); return; }
    Args a{};
    for (int i = 0; i < 24; ++i) a.in[i] = (const float*)d_in[i];
    a.out = (float*)d_out; a.ws = (unsigned char*)d_ws;
#if MK_PER_PHASE
    for (int p = 0; p < NPH; ++p) { a.ph_lo = p; a.ph_hi = p + 1; hipLaunchKernelGGL(mega_fwd, dim3(grid), dim3(NWAVES * 64), LDS_BYTES, stream, a); }
#else
    a.ph_lo = 0; a.ph_hi = NPH; hipLaunchKernelGGL(mega_fwd, dim3(grid), dim3(NWAVES * 64), LDS_BYTES, stream, a);
#endif
    const hipError_t le = hipPeekAtLastError();
    if (le != hipSuccess) fprintf(stderr, "kernel_launch: launch failed: %s\n", hipGetErrorName(le));
}
```

```cpp
#include <hip/hip_runtime.h>
#include <cstdio>
#include <cstdint>
__device__ __forceinline__ int opaque_tid() { int t = (int)threadIdx.x; asm volatile("" : "+v"(t)); return t; }
__device__ __forceinline__ int opaque_bid() { int b = (int)blockIdx.x; asm volatile("" : "+s"(b)); return b; }
__device__ __forceinline__ float opqf(float x) { asm volatile("" : "+v"(x)); return x; }
namespace pg8 {
#define PG8_LAS __attribute__((address_space(3)))
typedef unsigned short bf16_t;
typedef short bf16x8 __attribute__((ext_vector_type(8)));
typedef float f32x4 __attribute__((ext_vector_type(4)));
typedef unsigned u32x4 __attribute__((ext_vector_type(4)));
constexpr int BM = 256, BK = 64, HALF = 128, HTB = HALF * BK * 2  , STAGE_BYTES = 8 * HTB, NXCD = 8, WGM = 4;

__host__ __device__ __forceinline__ int lds_byte(int r, int c) { const int st = (r >> 4) * 2 + (c >> 5), rr = r & 15, cc = c & 31, ob = rr * 64 + cc * 2; return st * 1024 + (ob ^ (((ob >> 9) & 1) << 5)); }
__host__ __device__ __forceinline__ void stage_rc(int b, int& R, int& C) { const int st = b / 1024, sb = b % 1024, swz = sb ^ (((sb >> 9) & 1) << 5); R = (st >> 1) * 16 + swz / 64; C = (st & 1) * 32 + (swz % 64) / 2; }
__host__ __device__ __forceinline__ int perm32(int rho) { const int n = rho >> 4, i = rho & 15; return 8 * (i >> 2) + 4 * n + (i & 3); }

struct Unit { int pm, pn, ks, kofs; };
struct Gemm { const bf16_t* A; const bf16_t* Bt; int M, N, K, ld; };

struct StaticOrder {
    int nM, nN, nwg, G, c;
    __host__ __device__ void init(int M, int N, int G_, int c_) { nM = M / BM; nN = N / BM; nwg = nM * nN; G = G_; c = c_; }
    __host__ __device__ bool next(int i, Unit& u) const {
        const long L = (long)i * G + c; if (L >= nwg) return false;
        int wgid = (int)L; { const int q = nwg / NXCD, r = nwg % NXCD, xcd = wgid % NXCD, off = wgid / NXCD; wgid = (xcd < r ? xcd * (q + 1) : r * (q + 1) + (xcd - r) * q) + off; }
        const int nig = WGM * nN, gid = wgid / nig, fm = gid * WGM, gsz = (nM - fm) < WGM ? (nM - fm) : WGM;
        u.pm = fm + ((wgid % nig) % gsz); u.pn = (wgid % nig) / gsz; u.ks = 0; u.kofs = 0; return true;
    }
    __device__ __forceinline__ void a_ready(const Unit&) const {}
    __device__ __forceinline__ void done(const Unit&) const {}
};
__device__ __forceinline__ unsigned cvt_pk_bf16(float lo, float hi) { unsigned r; asm volatile("v_cvt_pk_bf16_f32 %0, %1, %2" : "=v"(r) : "v"(lo), "v"(hi)); return r; }
typedef float f32x2 __attribute__((ext_vector_type(2)));
constexpr float SS_FIX = 1048576.0f;
__device__ __forceinline__ float rstd_of(const unsigned long long* ss, int row) { const float s = (float)ss[row] * (1.0f / SS_FIX); return 1.0f / sqrtf(s * (1.0f / 4096.0f) + 1e-6f); }
struct EpiBf16 {
    static constexpr bool PERM = true, AFTER_DRAIN = false, MIDSCALE = false;
    bf16_t* O; int ldc; const unsigned long long* ss; const PG8_LAS float* rs; int rs_pm;
    __device__ __forceinline__ void operator()(const f32x4 (&acc)[2][2][4][2], const Unit& u, int wr, int wc, int fr, int fq) const {
        const int row0 = u.pm * BM + wr * 64 + fr, col0 = u.pn * BM + wc * 32 + 8 * fq;
        float rsv[8];
        if (!ss) {
#pragma unroll
            for (int k = 0; k < 8; ++k) rsv[k] = 1.0f;
        } else if (u.pm == rs_pm) {
#pragma unroll
            for (int k = 0; k < 8; ++k) rsv[k] = rs[wr * 64 + fr + (k >> 2) * HALF + (k & 3) * 16];
        } else {
#pragma unroll
            for (int k = 0; k < 8; ++k) rsv[k] = rstd_of(ss, row0 + (k >> 2) * HALF + (k & 3) * 16);
        }
#pragma unroll
        for (int ai = 0; ai < 2; ++ai)
#pragma unroll
            for (int m = 0; m < 4; ++m) { const int row = row0 + ai * HALF + m * 16; bf16_t* rowp = O + (size_t)row * ldc + col0; const float rs_ = rsv[ai * 4 + m];
#pragma unroll
                for (int bj = 0; bj < 2; ++bj) { const f32x4 v0 = acc[ai][bj][m][0] * rs_, v1 = acc[ai][bj][m][1] * rs_;
                    u32x4 w; w.x = cvt_pk_bf16(v0[0], v0[1]); w.y = cvt_pk_bf16(v0[2], v0[3]); w.z = cvt_pk_bf16(v1[0], v1[1]); w.w = cvt_pk_bf16(v1[2], v1[3]);
                    *(u32x4*)(rowp + bj * HALF) = w; } }
    }
};
__device__ __forceinline__ float silu_mul(float g, float u) { const float e = __builtin_amdgcn_exp2f(g * -1.4426950408889634f); return g * __builtin_amdgcn_rcpf(1.0f + e) * u; }
struct EpiSwiglu {
    static constexpr bool PERM = true, AFTER_DRAIN = false, MIDSCALE = false;
    bf16_t* O; int ldc; const unsigned long long* ss; const PG8_LAS float* rs; int rs_pm;
    __device__ __forceinline__ void operator()(const f32x4 (&acc)[2][2][4][2], const Unit& u, int wr, int wc, int fr, int fq) const {
        const int row0 = u.pm * BM + wr * 64 + fr, col0 = u.pn * HALF + wc * 32 + 8 * fq;
        float rsv[8];
        if (u.pm == rs_pm) {
#pragma unroll
            for (int k = 0; k < 8; ++k) rsv[k] = rs[wr * 64 + fr + (k >> 2) * HALF + (k & 3) * 16];
        } else {
#pragma unroll
            for (int k = 0; k < 8; ++k) rsv[k] = rstd_of(ss, row0 + (k >> 2) * HALF + (k & 3) * 16);
        }
#pragma unroll
        for (int ai = 0; ai < 2; ++ai)
#pragma unroll
            for (int m = 0; m < 4; ++m) { const int row = row0 + ai * HALF + m * 16; bf16_t* rowp = O + (size_t)row * ldc + col0; const float rs_ = rsv[ai * 4 + m];
                const f32x4 ag0 = acc[ai][0][m][0], ag1 = acc[ai][0][m][1], au0 = acc[ai][1][m][0], au1 = acc[ai][1][m][1];
                const float rsl = rs_ * -1.4426950408889634f, rs2 = rs_ * rs_;
                const f32x4 t0 = ag0 * rsl, t1 = ag1 * rsl; f32x4 e0, e1;
#pragma unroll
                for (int i = 0; i < 4; ++i) { e0[i] = __builtin_amdgcn_exp2f(t0[i]); e1[i] = __builtin_amdgcn_exp2f(t1[i]); }
                const f32x4 d0 = e0 + 1.0f, d1 = e1 + 1.0f; f32x4 r0, r1;
#pragma unroll
                for (int i = 0; i < 4; ++i) { r0[i] = __builtin_amdgcn_rcpf(d0[i]); r1[i] = __builtin_amdgcn_rcpf(d1[i]); }
                const f32x4 o0 = (ag0 * au0) * (r0 * rs2), o1 = (ag1 * au1) * (r1 * rs2);
                u32x4 w; w.x = cvt_pk_bf16(o0[0], o0[1]); w.y = cvt_pk_bf16(o0[2], o0[3]); w.z = cvt_pk_bf16(o1[0], o1[1]); w.w = cvt_pk_bf16(o1[2], o1[3]);
                *(u32x4*)rowp = w; }
    }
};
struct EpiResidBf {
    static constexpr bool PERM = true, AFTER_DRAIN = false, MIDSCALE = false;
    bf16_t* xb; int ldc; float alpha; unsigned long long* ss;
    __device__ __forceinline__ void operator()(const f32x4 (&acc)[2][2][4][2], const Unit& u, int wr, int wc, int fr, int fq) const {
        const int row0 = u.pm * BM + wr * 64 + fr, col0 = u.pn * BM + wc * 32 + 8 * fq;
        u32x4 b[2][4][2];
#pragma unroll
        for (int ai = 0; ai < 2; ++ai)
#pragma unroll
            for (int m = 0; m < 4; ++m)
#pragma unroll
                for (int bj = 0; bj < 2; ++bj) b[ai][m][bj] = *(const u32x4*)(xb + (size_t)(row0 + ai * HALF + m * 16) * ldc + col0 + bj * HALF);
#pragma unroll
        for (int ai = 0; ai < 2; ++ai)
#pragma unroll
            for (int m = 0; m < 4; ++m) { const int row = row0 + ai * HALF + m * 16; bf16_t* rowp = xb + (size_t)row * ldc + col0; float s = 0.f;
#pragma unroll
                for (int bj = 0; bj < 2; ++bj) { f32x4 v0, v1; const u32x4 bb = b[ai][m][bj];
                    v0[0] = __uint_as_float(bb.x << 16); v0[1] = __uint_as_float(bb.x & 0xffff0000u); v0[2] = __uint_as_float(bb.y << 16); v0[3] = __uint_as_float(bb.y & 0xffff0000u);
                    v1[0] = __uint_as_float(bb.z << 16); v1[1] = __uint_as_float(bb.z & 0xffff0000u); v1[2] = __uint_as_float(bb.w << 16); v1[3] = __uint_as_float(bb.w & 0xffff0000u);
                    v0 += acc[ai][bj][m][0] * alpha; v1 += acc[ai][bj][m][1] * alpha;
                    s += (v0[0] * v0[0] + v0[1] * v0[1]) + (v0[2] * v0[2] + v0[3] * v0[3]) + (v1[0] * v1[0] + v1[1] * v1[1]) + (v1[2] * v1[2] + v1[3] * v1[3]);
                    u32x4 w; w.x = cvt_pk_bf16(v0[0], v0[1]); w.y = cvt_pk_bf16(v0[2], v0[3]); w.z = cvt_pk_bf16(v1[0], v1[1]); w.w = cvt_pk_bf16(v1[2], v1[3]);
                    *(u32x4*)(rowp + bj * HALF) = w; }
                if (ss) { s += __shfl_xor(s, 16); s += __shfl_xor(s, 32);
                    if (fq == 0) __hip_atomic_fetch_add(ss + row, (unsigned long long)(s * SS_FIX + 0.5f), __ATOMIC_RELAXED, __HIP_MEMORY_SCOPE_AGENT); } }
    }
};
__device__ __forceinline__ float rstd2k_of(const unsigned long long* ss, int row) { const float s = (float)ss[row] * (1.0f / SS_FIX); return 1.0f / sqrtf(s * (1.0f / 2048.0f) + 1e-6f); }
struct EpiResidMid {
    static constexpr bool PERM = true, AFTER_DRAIN = false, MIDSCALE = true;
    bf16_t* xb; int ldc; unsigned long long* ss; const PG8_LAS float* tbl; int tpm; const unsigned long long* ssa; const unsigned long long* ssb;
    __device__ __forceinline__ void midscale(f32x4 (&acc)[2][2][4][2], const Unit& u, int wr, int fr) const {
        const bool inl = (u.pm == tpm); int rb_ = wr * 64 + fr; asm volatile("" : "+v"(rb_));
#pragma unroll
        for (int ai = 0; ai < 2; ++ai)
#pragma unroll
            for (int m = 0; m < 4; ++m) { const int ri = rb_ + ai * HALF + m * 16; float f;
                if (inl) f = tbl[ri]; else { const int row = u.pm * BM + ri; f = rstd2k_of(ssa, row) / rstd2k_of(ssb, row); }
#pragma unroll
                for (int bj = 0; bj < 2; ++bj)
#pragma unroll
                    for (int n = 0; n < 2; ++n) acc[ai][bj][m][n] *= f; }
    }
    __device__ __forceinline__ void operator()(const f32x4 (&acc)[2][2][4][2], const Unit& u, int wr, int wc, int fr, int fq) const {
        int rb_ = wr * 64 + fr; asm volatile("" : "+v"(rb_));
        const int row0 = u.pm * BM + rb_, col0 = u.pn * BM + wc * 32 + 8 * fq; const bool inl = (u.pm == tpm);
        u32x4 b[2][4][2];
#pragma unroll
        for (int ai = 0; ai < 2; ++ai)
#pragma unroll
            for (int m = 0; m < 4; ++m)
#pragma unroll
                for (int bj = 0; bj < 2; ++bj) b[ai][m][bj] = *(const u32x4*)(xb + (size_t)(row0 + ai * HALF + m * 16) * ldc + col0 + bj * HALF);
#pragma unroll
        for (int ai = 0; ai < 2; ++ai)
#pragma unroll
            for (int m = 0; m < 4; ++m) { const int row = row0 + ai * HALF + m * 16; bf16_t* rowp = xb + (size_t)row * ldc + col0; float s = 0.f; const float alpha = inl ? tbl[256 + rb_ + ai * HALF + m * 16] : rstd2k_of(ssb, row);
#pragma unroll
                for (int bj = 0; bj < 2; ++bj) { f32x4 v0, v1; const u32x4 bb = b[ai][m][bj];
                    v0[0] = __uint_as_float(bb.x << 16); v0[1] = __uint_as_float(bb.x & 0xffff0000u); v0[2] = __uint_as_float(bb.y << 16); v0[3] = __uint_as_float(bb.y & 0xffff0000u);
                    v1[0] = __uint_as_float(bb.z << 16); v1[1] = __uint_as_float(bb.z & 0xffff0000u); v1[2] = __uint_as_float(bb.w << 16); v1[3] = __uint_as_float(bb.w & 0xffff0000u);
                    v0 += acc[ai][bj][m][0] * alpha; v1 += acc[ai][bj][m][1] * alpha;
                    s += (v0[0] * v0[0] + v0[1] * v0[1]) + (v0[2] * v0[2] + v0[3] * v0[3]) + (v1[0] * v1[0] + v1[1] * v1[1]) + (v1[2] * v1[2] + v1[3] * v1[3]);
                    u32x4 w; w.x = cvt_pk_bf16(v0[0], v0[1]); w.y = cvt_pk_bf16(v0[2], v0[3]); w.z = cvt_pk_bf16(v1[0], v1[1]); w.w = cvt_pk_bf16(v1[2], v1[3]);
                    *(u32x4*)(rowp + bj * HALF) = w; }
                s += __shfl_xor(s, 16); s += __shfl_xor(s, 32);
                if (fq == 0) __hip_atomic_fetch_add(ss + row, (unsigned long long)(s * SS_FIX + 0.5f), __ATOMIC_RELAXED, __HIP_MEMORY_SCOPE_AGENT); }
    }
};
struct EpiF32Part {
    static constexpr bool PERM = false, AFTER_DRAIN = false, MIDSCALE = false;
    float* C; int ldc; size_t slice;
    __device__ __forceinline__ void operator()(const f32x4 (&acc)[2][2][4][2], const Unit& u, int wr, int wc, int fr, int fq) const {
        const int row0 = u.pm * BM + wr * 64 + fr, col0 = u.pn * BM + wc * 32 + 4 * fq; float* Cs = C + (size_t)u.ks * slice;
#pragma unroll
        for (int ai = 0; ai < 2; ++ai)
#pragma unroll
            for (int m = 0; m < 4; ++m) { float* rowp = Cs + (size_t)(row0 + ai * HALF + m * 16) * ldc + col0;
#pragma unroll
                for (int bj = 0; bj < 2; ++bj)
#pragma unroll
                    for (int n = 0; n < 2; ++n) *(f32x4*)(rowp + bj * HALF + n * 16) = acc[ai][bj][m][n]; }
    }
};
struct SplitK4Order {
    int v, G;
    __device__ bool next(int i, Unit& u) const { const int L = i * G + v; if (L >= 256) return false; u.pm = L >> 3; u.pn = (L >> 2) & 1; u.ks = L & 3; u.kofs = u.ks * 2048; return true; }
    __device__ __forceinline__ void a_ready(const Unit&) const {}
    __device__ __forceinline__ void done(const Unit&) const {}
};
struct KvOrder {
    int c;
    __device__ bool next(int i, Unit& u) const { if (i != 0 || c < 0 || c >= 8) return false; u.pm = c >> 2; u.pn = c; u.ks = 0; u.kofs = 0; return true; }
    __device__ __forceinline__ void a_ready(const Unit&) const {}
    __device__ __forceinline__ void done(const Unit&) const {}
};
template <class Epi, class Sched, bool ALIGN_EPI = false, bool SP2 = false>
__device__ __forceinline__ void gemm_phase(PG8_LAS unsigned char* lds, const Gemm g, const Sched& S, const Epi& E) {
    const int tid = opaque_tid(), wid = __builtin_amdgcn_readfirstlane(tid >> 6), lane = tid & 63, wr = wid >> 2, wc = wid & 3, fr = lane & 15, fq = lane >> 4;
    const int K = g.K, nt = K / BK;
    unsigned voffA[2], voffB[2];
#pragma unroll
    for (int i = 0; i < 2; ++i) { int R, C; stage_rc(tid * 16 + i * 8192, R, C); const int Rb = Epi::PERM ? ((R & ~31) + perm32(R & 31)) : R;
        voffA[i] = (unsigned)(R * g.ld + C) * 2u; voffB[i] = (unsigned)(Rb * g.ld + C) * 2u; }
    const size_t kstep = (size_t)(BK * 2);
    const size_t hstep = (size_t)HALF * g.ld * 2;
    const size_t tstep = 2 * hstep;
    const unsigned ldsw = (unsigned)wid * 1024u;
    const int aoff = lds_byte(wr * 64 + fr, fq * 8), boff = lds_byte(wc * 32 + fr, fq * 8);
#define PG8_SA(b, h) (((b) * 2 + (h)) * HTB)
#define PG8_SB(b, h) ((4 + (b) * 2 + (h)) * HTB)
#define PG8_STAGE(bufoff, gbase, voff) do { _Pragma("unroll") for (int _i = 0; _i < 2; ++_i) \
        __builtin_amdgcn_global_load_lds((const unsigned*)((const char*)(gbase) + (voff)[_i]), (PG8_LAS unsigned*)(lds + (bufoff) + ldsw + _i * 8192), 16, 0, 0); } while (0)
#define PG8_LDA(dst, b, h) do { _Pragma("unroll") for (int m = 0; m < 4; ++m) _Pragma("unroll") for (int k = 0; k < 2; ++k) dst[m][k] = *(const PG8_LAS bf16x8*)(lds + PG8_SA(b, h) + aoff + m * 2048 + k * 1024); } while (0)
#define PG8_LDB(dst, b, h) do { _Pragma("unroll") for (int n = 0; n < 2; ++n) _Pragma("unroll") for (int k = 0; k < 2; ++k) dst[n][k] = *(const PG8_LAS bf16x8*)(lds + PG8_SB(b, h) + boff + n * 2048 + k * 1024); } while (0)
#define PG8_MMA(ai, bj, At, Bt) do { __builtin_amdgcn_s_setprio(1); _Pragma("unroll") for (int m = 0; m < 4; ++m) _Pragma("unroll") for (int n = 0; n < 2; ++n) _Pragma("unroll") for (int k = 0; k < 2; ++k) \
        acc[ai][bj][m][n] = __builtin_amdgcn_mfma_f32_16x16x32_bf16(Bt[n][k], At[m][k], acc[ai][bj][m][n], 0, 0, 0); __builtin_amdgcn_s_setprio(0); } while (0)
#define PG8_WAIT_V(n) asm volatile("s_waitcnt vmcnt(" #n ")" ::: "memory")
#define PG8_WAIT_L(n) asm volatile("s_waitcnt lgkmcnt(" #n ")" ::: "memory")
#define PG8_BAR __builtin_amdgcn_s_barrier()
#define PG8_SCHED __builtin_amdgcn_sched_barrier(0)
    Unit cur, nxt; int ui = 0;
    if (!S.next(0, cur)) return;
    f32x4 acc[2][2][4][2];
#pragma unroll
    for (int a = 0; a < 2; ++a)
#pragma unroll
        for (int b = 0; b < 2; ++b)
#pragma unroll
            for (int m = 0; m < 4; ++m)
#pragma unroll
                for (int n = 0; n < 2; ++n) acc[a][b][m][n] = (f32x4){0.f, 0.f, 0.f, 0.f};
    bf16x8 At[4][2], B0[2][2], B1[2][2];
    const char* cA = (const char*)g.A + (size_t)cur.pm * tstep + cur.kofs; const char* cB = (const char*)g.Bt + (size_t)cur.pn * tstep + cur.kofs;
    S.a_ready(cur);
    if constexpr (SP2) {
        PG8_STAGE(PG8_SB(0, 0), cB, voffB); PG8_STAGE(PG8_SB(0, 1), cB + hstep, voffB); PG8_STAGE(PG8_SA(0, 0), cA, voffA); PG8_STAGE(PG8_SA(0, 1), cA + hstep, voffA);
        if (wr == 1) PG8_BAR;
        PG8_WAIT_V(2); PG8_BAR;
        PG8_STAGE(PG8_SB(1, 0), cB + kstep, voffB); PG8_STAGE(PG8_SA(1, 0), cA + kstep, voffA); PG8_STAGE(PG8_SB(1, 1), cB + hstep + kstep, voffB);
        PG8_WAIT_V(6); PG8_BAR;
    } else {
        PG8_STAGE(PG8_SB(0, 0), cB, voffB); PG8_STAGE(PG8_SA(0, 0), cA, voffA); PG8_STAGE(PG8_SB(0, 1), cB + hstep, voffB); PG8_STAGE(PG8_SA(0, 1), cA + hstep, voffA);
        if (wr == 1) PG8_BAR;
        PG8_WAIT_V(4); PG8_BAR;
        PG8_STAGE(PG8_SB(1, 0), cB + kstep, voffB); PG8_STAGE(PG8_SA(1, 0), cA + kstep, voffA); PG8_STAGE(PG8_SB(1, 1), cB + hstep + kstep, voffB);
        PG8_WAIT_V(6); PG8_BAR;
    }
    for (;;) {
        const bool has_next = S.next(ui + 1, nxt);
        const char* nA = has_next ? (const char*)g.A + (size_t)nxt.pm * tstep + nxt.kofs : cA; const char* nB = has_next ? (const char*)g.Bt + (size_t)nxt.pn * tstep + nxt.kofs : cB;
        _Pragma("clang loop unroll(disable)") for (int th = 0; th < (Epi::MIDSCALE ? 2 : 1); ++th) {
        const int tb = Epi::MIDSCALE ? th * (nt >> 1) : 0, te = Epi::MIDSCALE ? tb + (nt >> 1) : nt;
        for (int t = tb; t < te; t += 2) {
            const bool last = (t == nt - 2);
            const char* a1 = cA + (size_t)(t + 1) * kstep;
            const char* a2 = last ? nA : cA + (size_t)(t + 2) * kstep; const char* b2 = last ? nB : cB + (size_t)(t + 2) * kstep;
            const char* a3 = a2 + kstep; const char* b3 = b2 + kstep;
            if (last && has_next) S.a_ready(nxt);
            if constexpr (SP2) {
            PG8_LDB(B0, 0, 0); PG8_LDB(B1, 0, 1); PG8_SCHED; PG8_LDA(At, 0, 0); PG8_STAGE(PG8_SA(1, 1), a1 + hstep, voffA);
            PG8_WAIT_V(8); PG8_WAIT_L(0); PG8_BAR; PG8_MMA(0, 0, At, B0); PG8_MMA(0, 1, At, B1); PG8_BAR; PG8_SCHED;
            PG8_LDA(At, 0, 1); PG8_STAGE(PG8_SB(0, 0), b2, voffB); PG8_STAGE(PG8_SB(0, 1), b2 + hstep, voffB); PG8_STAGE(PG8_SA(0, 0), a2, voffA);
            PG8_WAIT_V(8); PG8_WAIT_L(0); PG8_BAR; PG8_MMA(1, 0, At, B0); PG8_MMA(1, 1, At, B1); PG8_BAR; PG8_SCHED;
            PG8_LDB(B0, 1, 0); PG8_LDB(B1, 1, 1); PG8_SCHED; PG8_LDA(At, 1, 0); PG8_STAGE(PG8_SA(0, 1), a2 + hstep, voffA);
            PG8_WAIT_V(8); PG8_WAIT_L(0); PG8_BAR; PG8_MMA(0, 0, At, B0); PG8_MMA(0, 1, At, B1); PG8_BAR; PG8_SCHED;
            PG8_LDA(At, 1, 1); PG8_STAGE(PG8_SB(1, 0), b3, voffB); PG8_STAGE(PG8_SB(1, 1), b3 + hstep, voffB); PG8_STAGE(PG8_SA(1, 0), a3, voffA);
            PG8_WAIT_V(8); PG8_WAIT_L(0); PG8_BAR; PG8_MMA(1, 0, At, B0); PG8_MMA(1, 1, At, B1); PG8_BAR; PG8_SCHED;
            } else {
            PG8_LDB(B0, 0, 0); PG8_SCHED; PG8_LDA(At, 0, 0); PG8_STAGE(PG8_SA(1, 1), a1 + hstep, voffA);
            PG8_WAIT_L(8); PG8_BAR; PG8_WAIT_L(0); PG8_MMA(0, 0, At, B0); PG8_BAR; PG8_SCHED;
            PG8_LDB(B1, 0, 1); PG8_STAGE(PG8_SB(0, 0), b2, voffB);
            PG8_BAR; PG8_WAIT_L(0); PG8_MMA(0, 1, At, B1); PG8_BAR;
            PG8_LDA(At, 0, 1); PG8_STAGE(PG8_SA(0, 0), a2, voffA);
            PG8_BAR; PG8_WAIT_L(0); PG8_MMA(1, 0, At, B0); PG8_BAR; PG8_SCHED;
            PG8_STAGE(PG8_SB(0, 1), b2 + hstep, voffB);
            PG8_WAIT_V(6); PG8_BAR; PG8_MMA(1, 1, At, B1); PG8_BAR;
            PG8_LDB(B0, 1, 0); PG8_SCHED; PG8_LDA(At, 1, 0); PG8_STAGE(PG8_SA(0, 1), a2 + hstep, voffA);
            PG8_WAIT_L(8); PG8_BAR; PG8_WAIT_L(0); PG8_MMA(0, 0, At, B0); PG8_BAR; PG8_SCHED;
            PG8_LDB(B1, 1, 1); PG8_STAGE(PG8_SB(1, 0), b3, voffB);
            PG8_BAR; PG8_WAIT_L(0); PG8_MMA(0, 1, At, B1); PG8_BAR;
            PG8_LDA(At, 1, 1); PG8_STAGE(PG8_SA(1, 0), a3, voffA);
            PG8_BAR; PG8_WAIT_L(0); PG8_MMA(1, 0, At, B0); PG8_BAR; PG8_SCHED;
            PG8_STAGE(PG8_SB(1, 1), b3 + hstep, voffB);
            PG8_WAIT_V(6); PG8_BAR; PG8_MMA(1, 1, At, B1); PG8_BAR;
            }
        }
        if constexpr (Epi::MIDSCALE) { if (th == 0) { PG8_SCHED; E.midscale(acc, cur, wr, fr); PG8_SCHED; } }
        }
        if constexpr (ALIGN_EPI) { if (wr == 0) PG8_BAR; }
        if constexpr (!Epi::AFTER_DRAIN) { E(acc, cur, wr, wc, fr, fq); S.done(cur); }
        if (!has_next) break;
#pragma unroll
        for (int a = 0; a < 2; ++a)
#pragma unroll
            for (int b = 0; b < 2; ++b)
#pragma unroll
                for (int m = 0; m < 4; ++m)
#pragma unroll
                    for (int n = 0; n < 2; ++n) acc[a][b][m][n] = (f32x4){0.f, 0.f, 0.f, 0.f};
        cur = nxt; cA = nA; cB = nB; ++ui;
        if constexpr (ALIGN_EPI) { if (wr == 1) PG8_BAR; }
    }
    PG8_WAIT_V(0);
    if constexpr (!ALIGN_EPI) { if (wr == 0) PG8_BAR; }
    PG8_BAR;
    if constexpr (Epi::AFTER_DRAIN) { E.fused(acc, cur, wr, wc, fr, fq, lds, wid, lane); S.done(cur); }
#undef PG8_SA
#undef PG8_SB
#undef PG8_STAGE
#undef PG8_LDA
#undef PG8_LDB
#undef PG8_MMA
#undef PG8_WAIT_V
#undef PG8_WAIT_L
#undef PG8_BAR
#undef PG8_SCHED
}
}
namespace att {
typedef unsigned short bf16;
constexpr int   D = 128, NW = 8, QBLK = 32, KVBLK = 64;
constexpr float SCALE = 0.088388347648318440f;
constexpr float THR = 8.f;
constexpr size_t SHM_V = KVBLK * D * 2, SHM_K = KVBLK * D * 2, SHM_ATTN = 2 * SHM_V + 2 * SHM_K + NW * 64 * 4;
using bf16x8 = __attribute__((ext_vector_type(8))) short;
using s16x4  = __attribute__((ext_vector_type(4))) short;
using f32x16 = __attribute__((ext_vector_type(16))) float;
using u32x4  = __attribute__((ext_vector_type(4))) unsigned;
using f32x4  = __attribute__((ext_vector_type(4))) float;
#define KSWZ(row, colB) ((row) * 256 + ((colB) ^ (((row) & 7) << 4)))
#define SBAR() __builtin_amdgcn_sched_barrier(0)
#ifndef ATT_PRESCALED
#define ATT_PRESCALED 1
#endif
__device__ __forceinline__ int crow(int r, int hi) { return (r & 3) + 8 * (r >> 2) + 4 * hi; }
__device__ __forceinline__ unsigned cvtpk(float lo, float hi) {
  unsigned r; asm volatile("v_cvt_pk_bf16_f32 %0, %1, %2" : "=v"(r) : "v"(lo), "v"(hi)); return r;
}
__device__ __forceinline__ bf16x8 ld8(const bf16* p) { return *reinterpret_cast<const bf16x8*>(p); }

__device__ __forceinline__ void partialSM(f32x16& p0, f32x16& p1, float& m_reg, float& mn, float& alpha) {
  constexpr float C = SCALE * 1.4426950408889634f;
  float pmax = p0[0]; for (int r = 1; r < 16; ++r) pmax = fmaxf(pmax, p0[r]); for (int r = 0; r < 16; ++r) pmax = fmaxf(pmax, p1[r]);
  { auto rr = __builtin_amdgcn_permlane32_swap(__float_as_uint(pmax), __float_as_uint(pmax), false, false);
    pmax = fmaxf(__uint_as_float(rr[0]), __uint_as_float(rr[1])); }
  if (__builtin_expect(__all(pmax - m_reg <= THR / SCALE), 1)) { mn = m_reg; alpha = 1.f; }
  else { mn = fmaxf(m_reg, pmax); alpha = __builtin_amdgcn_exp2f((m_reg - mn) * C); m_reg = mn; }
  float mnC = -mn * C;
  for (int r = 0; r < 16; ++r) p0[r] = fmaf(p0[r], C, mnC); for (int r = 0; r < 16; ++r) p1[r] = fmaf(p1[r], C, mnC);
  for (int r = 0; r < 16; ++r) p0[r] = __builtin_amdgcn_exp2f(p0[r]);
}
__device__ __forceinline__ void partialSM_fixed(f32x16& p0, f32x16& p1, float negb2) {
#if ATT_PRESCALED
  if (negb2 != 0.f) { for (int r = 0; r < 16; ++r) p0[r] += negb2; for (int r = 0; r < 16; ++r) p1[r] += negb2; }
#else
  constexpr float C = SCALE * 1.4426950408889634f;
  for (int r = 0; r < 16; ++r) p0[r] = fmaf(p0[r], C, negb2); for (int r = 0; r < 16; ++r) p1[r] = fmaf(p1[r], C, negb2);
#endif
  for (int r = 0; r < 16; ++r) p0[r] = __builtin_amdgcn_exp2f(p0[r]);
}
__device__ __forceinline__ void finishSM(f32x16& p0, f32x16& p1, float alpha, float& l_reg, bf16x8& pa0, bf16x8& pa1, bf16x8& pa2, bf16x8& pa3) {
  for (int r = 0; r < 16; ++r) p1[r] = __builtin_amdgcn_exp2f(p1[r]);
  float ps = 0; for (int r = 0; r < 16; ++r) ps += p0[r]; for (int r = 0; r < 16; ++r) ps += p1[r];
  { auto rr = __builtin_amdgcn_permlane32_swap(__float_as_uint(ps), __float_as_uint(ps), false, false);
    ps = __uint_as_float(rr[0]) + __uint_as_float(rr[1]); }
  l_reg = l_reg * alpha + ps;
#define PK4(P, BASE, OUT) do { unsigned a0 = cvtpk(P[BASE + 0], P[BASE + 1]), a1 = cvtpk(P[BASE + 2], P[BASE + 3]);   \
    unsigned b0 = cvtpk(P[BASE + 4], P[BASE + 5]), b1 = cvtpk(P[BASE + 6], P[BASE + 7]);                              \
    auto r0 = __builtin_amdgcn_permlane32_swap(a0, b0, false, false); auto r1 = __builtin_amdgcn_permlane32_swap(a1, b1, false, false); \
    u32x4 w = {r0[0], r1[0], r0[1], r1[1]}; OUT = *reinterpret_cast<bf16x8*>(&w); } while (0)
  PK4(p0, 0, pa0); PK4(p0, 8, pa1); PK4(p1, 0, pa2); PK4(p1, 8, pa3);
#undef PK4
}
__device__ __forceinline__ void finishSM_fixed(f32x16& p0, f32x16& p1, bf16x8& pa0, bf16x8& pa1, bf16x8& pa2, bf16x8& pa3) {
  for (int r = 0; r < 16; ++r) p1[r] = __builtin_amdgcn_exp2f(p1[r]);
#define PK4(P, BASE, OUT) do { unsigned a0 = cvtpk(P[BASE + 0], P[BASE + 1]), a1 = cvtpk(P[BASE + 2], P[BASE + 3]);   \
    unsigned b0 = cvtpk(P[BASE + 4], P[BASE + 5]), b1 = cvtpk(P[BASE + 6], P[BASE + 7]);                              \
    auto r0 = __builtin_amdgcn_permlane32_swap(a0, b0, false, false); auto r1 = __builtin_amdgcn_permlane32_swap(a1, b1, false, false); \
    u32x4 w = {r0[0], r1[0], r0[1], r1[1]}; OUT = *reinterpret_cast<bf16x8*>(&w); } while (0)
  PK4(p0, 0, pa0); PK4(p0, 8, pa1); PK4(p1, 0, pa2); PK4(p1, 8, pa3);
#undef PK4
}
__device__ __forceinline__ void qkt(f32x16& p0, f32x16& p1, const bf16* Ks, const bf16x8* qr, int r32, int hi) {
  p0 = f32x16{}; p1 = f32x16{};
  for (int d0 = 0; d0 < 8; ++d0) { int cb = (d0 * 16 + hi * 8) * 2;
    bf16x8 b0 = *reinterpret_cast<const bf16x8*>((const char*)Ks + KSWZ(r32, cb));
    bf16x8 b1 = *reinterpret_cast<const bf16x8*>((const char*)Ks + KSWZ(32 + r32, cb));
    p0 = __builtin_amdgcn_mfma_f32_32x32x16_bf16(b0, qr[d0], p0, 0, 0, 0);
    p1 = __builtin_amdgcn_mfma_f32_32x32x16_bf16(b1, qr[d0], p1, 0, 0, 0); }
}
__device__ __forceinline__ int v_st(int k, int c) { const int kk = (k & ~0xC) | ((k & 4) << 1) | ((k & 8) >> 1); return ((kk >> 3) * 4 + (c >> 5)) * 512 + ((kk & 7) * 32 + (c & 31)) * 2; }
__device__ __forceinline__ int v_rd_base(int lane) { return ((lane & 3) << 3) | (((lane >> 2) & 3) << 6) | (((lane >> 4) & 1) << 5) | (((lane >> 5) & 1) << 8); }
constexpr int v_rd_off(int d0, int ks, int half) { return d0 * 512 + ks * 4096 + half * 2048; }
template <int OFF> __device__ __forceinline__ s16x4 tr_read(int vb) {
  s16x4 r; asm volatile("ds_read_b64_tr_b16 %0, %1 offset:%2" : "=&v"(r) : "v"(vb), "i"(OFF) : "memory"); return r;
}
template <int D0, bool LSUM = false> __device__ __forceinline__ void pv_one(f32x16& od, int vb, bf16x8 pa0, bf16x8 pa1, bf16x8 pa2, bf16x8 pa3, f32x4* ol = nullptr, bf16x8 osel = bf16x8{}) {
  const s16x4 l0 = tr_read<v_rd_off(D0, 0, 0)>(vb), h0 = tr_read<v_rd_off(D0, 0, 1)>(vb), l1 = tr_read<v_rd_off(D0, 1, 0)>(vb), h1 = tr_read<v_rd_off(D0, 1, 1)>(vb);
  const s16x4 l2 = tr_read<v_rd_off(D0, 2, 0)>(vb), h2 = tr_read<v_rd_off(D0, 2, 1)>(vb), l3 = tr_read<v_rd_off(D0, 3, 0)>(vb), h3 = tr_read<v_rd_off(D0, 3, 1)>(vb);
  if constexpr (LSUM)
    *ol = __builtin_amdgcn_mfma_f32_16x16x32_bf16(D0 == 0 ? pa0 : D0 == 1 ? pa1 : D0 == 2 ? pa2 : pa3, osel, *ol, 0, 0, 0);
  asm volatile("s_waitcnt lgkmcnt(0)" ::: "memory"); SBAR();
#define PK(L, H) (bf16x8){L[0], L[1], L[2], L[3], H[0], H[1], H[2], H[3]}
  od = __builtin_amdgcn_mfma_f32_32x32x16_bf16(pa0, PK(l0, h0), od, 0, 0, 0);
  od = __builtin_amdgcn_mfma_f32_32x32x16_bf16(pa1, PK(l1, h1), od, 0, 0, 0);
  od = __builtin_amdgcn_mfma_f32_32x32x16_bf16(pa2, PK(l2, h2), od, 0, 0, 0);
  od = __builtin_amdgcn_mfma_f32_32x32x16_bf16(pa3, PK(l3, h3), od, 0, 0, 0);
#undef PK
}
template <bool LSUM = false> __device__ __forceinline__ void pv_d0(f32x16* o, int vb, bf16x8 pa0, bf16x8 pa1, bf16x8 pa2, bf16x8 pa3, f32x4* ol = nullptr, bf16x8 osel = bf16x8{}) {
  pv_one<0, LSUM>(o[0], vb, pa0, pa1, pa2, pa3, ol, osel); pv_one<1, LSUM>(o[1], vb, pa0, pa1, pa2, pa3, ol, osel); pv_one<2, LSUM>(o[2], vb, pa0, pa1, pa2, pa3, ol, osel); pv_one<3, LSUM>(o[3], vb, pa0, pa1, pa2, pa3, ol, osel);
}

#define PKA(P, BASE) do { ta0 = cvtpk(P[BASE + 0], P[BASE + 1]); ta1 = cvtpk(P[BASE + 2], P[BASE + 3]); } while (0)
#define PKB(P, BASE) do { tb0 = cvtpk(P[BASE + 4], P[BASE + 5]); tb1 = cvtpk(P[BASE + 6], P[BASE + 7]); } while (0)
#define PKC(OUT) do { auto r0 = __builtin_amdgcn_permlane32_swap(ta0, tb0, false, false); auto r1 = __builtin_amdgcn_permlane32_swap(ta1, tb1, false, false); \
    u32x4 w = {r0[0], r1[0], r0[1], r1[1]}; OUT = *reinterpret_cast<bf16x8*>(&w); } while (0)
__device__ __forceinline__ void qkt_fin(f32x16& n0, f32x16& n1, const bf16* Ks, const bf16x8* qr, int r32, int hi, f32x16& o0, f32x16& o1, bf16x8& pa0, bf16x8& pa1, bf16x8& pa2, bf16x8& pa3) {
  n0 = f32x16{}; n1 = f32x16{};
  bf16x8 kb[2][2]; unsigned ta0 = 0, ta1 = 0, tb0 = 0, tb1 = 0;
#define KLD(d0_, half_) do { const int cb = ((d0_) * 16 + hi * 8) * 2; kb[(d0_) & 1][half_] = *reinterpret_cast<const bf16x8*>((const char*)Ks + KSWZ((half_) * 32 + r32, cb)); } while (0)
#define EX(i_) o1[i_] = __builtin_amdgcn_exp2f(o1[i_])
  KLD(0, 0); KLD(0, 1); KLD(1, 0);
#pragma unroll
  for (int d0 = 0; d0 < 8; ++d0) {
    if (d0 + 1 < 8) KLD(d0 + 1, 1);
    n0 = __builtin_amdgcn_mfma_f32_32x32x16_bf16(kb[d0 & 1][0], qr[d0], n0, 0, 0, 0);
    { const int g = 2 * d0;
      if (g < 4) { EX(2 * g); EX(2 * g + 1); } else if (g < 12) EX(8 + (g - 4));
      if (g == 0) PKA(o0, 0); if (g == 2) PKC(pa0); if (g == 4) PKB(o0, 8); if (g == 6) PKA(o1, 0); if (g == 8) PKC(pa2); if (g == 12) PKA(o1, 8); if (g == 14) PKC(pa3); }
    SBAR();
    if (d0 + 2 < 8) KLD(d0 + 2, 0);
    n1 = __builtin_amdgcn_mfma_f32_32x32x16_bf16(kb[d0 & 1][1], qr[d0], n1, 0, 0, 0);
    { const int g = 2 * d0 + 1;
      if (g < 4) { EX(2 * g); EX(2 * g + 1); } else if (g < 12) EX(8 + (g - 4));
      if (g == 1) PKB(o0, 0); if (g == 3) PKA(o0, 8); if (g == 5) PKC(pa1); if (g == 7) PKB(o1, 0); if (g == 13) PKB(o1, 8); }
    SBAR();
  }
#undef KLD
#undef EX
}
#undef PKA
#undef PKB
#undef PKC
template <int D0> __device__ __forceinline__ void pv_one_x(f32x16& od, int vb, bf16x8 pa0, bf16x8 pa1, bf16x8 pa2, bf16x8 pa3, f32x4& ol, bf16x8 osel, f32x16& n0) {
  const s16x4 l0 = tr_read<v_rd_off(D0, 0, 0)>(vb), h0 = tr_read<v_rd_off(D0, 0, 1)>(vb), l1 = tr_read<v_rd_off(D0, 1, 0)>(vb), h1 = tr_read<v_rd_off(D0, 1, 1)>(vb);
  const s16x4 l2 = tr_read<v_rd_off(D0, 2, 0)>(vb), h2 = tr_read<v_rd_off(D0, 2, 1)>(vb), l3 = tr_read<v_rd_off(D0, 3, 0)>(vb), h3 = tr_read<v_rd_off(D0, 3, 1)>(vb);
  ol = __builtin_amdgcn_mfma_f32_16x16x32_bf16(D0 == 0 ? pa0 : D0 == 1 ? pa1 : D0 == 2 ? pa2 : pa3, osel, ol, 0, 0, 0);
  n0[4 * D0] = __builtin_amdgcn_exp2f(n0[4 * D0]);
  asm volatile("s_waitcnt lgkmcnt(0)" ::: "memory"); SBAR();
#define PK(L, H) (bf16x8){L[0], L[1], L[2], L[3], H[0], H[1], H[2], H[3]}
  od = __builtin_amdgcn_mfma_f32_32x32x16_bf16(pa0, PK(l0, h0), od, 0, 0, 0); n0[4 * D0 + 1] = __builtin_amdgcn_exp2f(n0[4 * D0 + 1]); SBAR();
  od = __builtin_amdgcn_mfma_f32_32x32x16_bf16(pa1, PK(l1, h1), od, 0, 0, 0); n0[4 * D0 + 2] = __builtin_amdgcn_exp2f(n0[4 * D0 + 2]); SBAR();
  od = __builtin_amdgcn_mfma_f32_32x32x16_bf16(pa2, PK(l2, h2), od, 0, 0, 0); n0[4 * D0 + 3] = __builtin_amdgcn_exp2f(n0[4 * D0 + 3]); SBAR();
  od = __builtin_amdgcn_mfma_f32_32x32x16_bf16(pa3, PK(l3, h3), od, 0, 0, 0);
#undef PK
}
__device__ __forceinline__ void pv_exp(f32x16* o, int vb, bf16x8 pa0, bf16x8 pa1, bf16x8 pa2, bf16x8 pa3, f32x4& ol, bf16x8 osel, f32x16& n0, f32x16& n1, float negb2) {
  if (negb2 != 0.f) { for (int r = 0; r < 16; ++r) n0[r] += negb2; for (int r = 0; r < 16; ++r) n1[r] += negb2; }
  pv_one_x<0>(o[0], vb, pa0, pa1, pa2, pa3, ol, osel, n0); pv_one_x<1>(o[1], vb, pa0, pa1, pa2, pa3, ol, osel, n0); pv_one_x<2>(o[2], vb, pa0, pa1, pa2, pa3, ol, osel, n0); pv_one_x<3>(o[3], vb, pa0, pa1, pa2, pa3, ol, osel, n0);
}
struct BfQ { const bf16* p; int ld;
  __device__ __forceinline__ bf16x8 operator()(int r, int d) const { return ld8(p + (long)r * ld + d); } };
struct NoHook { __device__ __forceinline__ void operator()(f32x16&, f32x16&, int, int, int, int) const {} };

template <int LDK, int LDO, int SDEPTH, bool FIXM, class QLoad, class Hook, bool ODDNT = false>
__device__ __forceinline__ void attn_dense_body(const QLoad& ql, const bf16* __restrict__ Kh, const bf16* __restrict__ Vh,
                                                bf16* __restrict__ Ob, int seq, char* lds, const Hook& hook, unsigned long long* ssrow = nullptr, float negb2 = 0.f) {
  const int tid = opaque_tid(), wid = tid >> 6, lane = tid & 63, r32 = lane & 31, hi = lane >> 5;
  bf16* V_lds = (bf16*)lds; bf16* K_lds = (bf16*)(lds + 2 * SHM_V);
  float* ws = (float*)(lds + ((FIXM && ATT_PRESCALED) ? 6 : 4) * SHM_V) + wid * 64; float* li_l = ws; float* al_l = ws + 32;
  float m_reg = -1e30f, l_reg = 0; f32x16 o[4] = {}; f32x4 ol = {}; bf16x8 qr[8];
  bf16x8 osel; { const short ov = (((lane >> 4) & 1) == ((lane >> 3) & 1)) ? (short)0x3F80 : (short)0; osel = bf16x8{ov, ov, ov, ov, ov, ov, ov, ov}; }
#pragma unroll
  for (int d0 = 0; d0 < 8; ++d0) qr[d0] = ql(wid * QBLK + r32, hi * 8 + d0 * 16);
  const int sr = tid >> 4, sc = (tid & 15) * 8, vst0 = v_st(sr, sc), vst1 = v_st(32 + sr, sc);
  const int vb0 = (int)(uintptr_t)V_lds + v_rd_base(lane);
  struct { bf16x8 vs0, vs1, ks0, ks1; } sr_[SDEPTH];
#define SLOAD(i, k0) do { sr_[i].vs0 = ld8(&Vh[(long)((k0) + sr) * LDK + sc]); sr_[i].vs1 = ld8(&Vh[(long)((k0) + 32 + sr) * LDK + sc]); \
    sr_[i].ks0 = ld8(&Kh[(long)((k0) + sr) * LDK + sc]); sr_[i].ks1 = ld8(&Kh[(long)((k0) + 32 + sr) * LDK + sc]); } while (0)
#define SWRITE(b, i) do { *(bf16x8*)((char*)V_lds + (b) * SHM_V + vst0) = sr_[i].vs0;          \
    *(bf16x8*)((char*)V_lds + (b) * SHM_V + vst1) = sr_[i].vs1; int kc = sc * 2;               \
    *(bf16x8*)((char*)K_lds + (b) * SHM_K + KSWZ(sr, kc)) = sr_[i].ks0;                       \
    *(bf16x8*)((char*)K_lds + (b) * SHM_K + KSWZ(32 + sr, kc)) = sr_[i].ks1; } while (0)
#define SWAIT() do { if constexpr (SDEPTH == 2) asm volatile("s_waitcnt vmcnt(4)" ::: "memory"); else asm volatile("s_waitcnt vmcnt(0)" ::: "memory"); } while (0)
#define RESC(a) do { if (__any((a) < 1.f)) { if (hi == 0) al_l[r32] = (a); asm volatile("s_waitcnt lgkmcnt(0)" ::: "memory"); \
    for (int d = 0; d < 4; ++d) for (int r = 0; r < 16; ++r) o[d][r] *= al_l[crow(r, hi)]; } } while (0)
#define PSM(P0, P1, MN, AL) do { if constexpr (FIXM) { partialSM_fixed(P0, P1, negb2); AL = 1.f; } else partialSM(P0, P1, m_reg, MN, AL); } while (0)
#define RESCF(a) do { if constexpr (!FIXM) RESC(a); } while (0)
#define FSM(P0, P1, AL) do { if constexpr (FIXM) finishSM_fixed(P0, P1, pa0, pa1, pa2, pa3); else finishSM(P0, P1, AL, l_reg, pa0, pa1, pa2, pa3); } while (0)
  f32x16 pA0, pA1, pB0, pB1; float mnA, mnB, alA, alB; bf16x8 pa0, pa1, pa2, pa3; const int NT = seq / KVBLK;
  constexpr int SE = 0, SO = SDEPTH - 1;
  if constexpr (FIXM && ATT_PRESCALED) {
    typedef __attribute__((address_space(3))) unsigned* lds_u32p;
    char* const V3 = lds; char* const K3 = lds + 3 * SHM_V; const int vb3 = (int)(uintptr_t)V3 + v_rd_base(lane);
    int kof[2], vof[2];
#pragma unroll
    for (int i = 0; i < 2; ++i) { const int p = wid * 2 + i;
      { const int row = 4 * p + (lane >> 4), cg = (lane & 15) ^ (row & 7); kof[i] = row * LDK + cg * 8; }
      { const int st = 2 * p + (lane >> 5), kk = (st >> 2) * 8 + ((lane & 31) >> 2), k = (kk & ~0xC) | ((kk & 4) << 1) | ((kk & 8) >> 1), c = (st & 3) * 32 + (lane & 3) * 8; vof[i] = k * LDK + c; } }
    const unsigned ldsp = (unsigned)wid * 2048u;
#define DMA3(b, k0) do { const bf16* kg = Kh + (long)(k0) * LDK; const bf16* vg = Vh + (long)(k0) * LDK; _Pragma("unroll") for (int i_ = 0; i_ < 2; ++i_) { \
      __builtin_amdgcn_global_load_lds((const unsigned*)(kg + kof[i_]), (lds_u32p)(K3 + (b) * (int)SHM_K + ldsp + i_ * 1024), 16, 0, 0); \
      __builtin_amdgcn_global_load_lds((const unsigned*)(vg + vof[i_]), (lds_u32p)(V3 + (b) * (int)SHM_V + ldsp + i_ * 1024), 16, 0, 0); } } while (0)
#define VMW0() asm volatile("s_waitcnt vmcnt(0)" ::: "memory")
    DMA3(0, 0); DMA3(1, KVBLK); VMW0(); __syncthreads();
    qkt(pA0, pA1, (const bf16*)K3, qr, r32, hi); PSM(pA0, pA1, mnA, alA);
    int bj = 1;
    for (int j = 1; j + 1 < NT; j += 2) {
      const int b0_ = bj, b1_ = bj == 2 ? 0 : bj + 1, b2_ = b1_ == 2 ? 0 : b1_ + 1, bm_ = bj == 0 ? 2 : bj - 1;
      DMA3(b1_, (j + 1) * KVBLK);
      SBAR(); qkt_fin(pB0, pB1, (const bf16*)(K3 + b0_ * (int)SHM_K), qr, r32, hi, pA0, pA1, pa0, pa1, pa2, pa3); SBAR();
      pv_exp(o, vb3 + bm_ * (int)SHM_V, pa0, pa1, pa2, pa3, ol, osel, pB0, pB1, negb2);
      VMW0(); __syncthreads();
      if (j + 2 < NT) DMA3(b2_, (j + 2) * KVBLK);
      SBAR(); qkt_fin(pA0, pA1, (const bf16*)(K3 + b1_ * (int)SHM_K), qr, r32, hi, pB0, pB1, pa0, pa1, pa2, pa3); SBAR();
      pv_exp(o, vb3 + b0_ * (int)SHM_V, pa0, pa1, pa2, pa3, ol, osel, pA0, pA1, negb2);
      VMW0(); __syncthreads();
      bj = b2_;
    }
    { const int b0_ = bj, bm_ = bj == 0 ? 2 : bj - 1;
      SBAR(); qkt_fin(pB0, pB1, (const bf16*)(K3 + b0_ * (int)SHM_K), qr, r32, hi, pA0, pA1, pa0, pa1, pa2, pa3); SBAR();
      pv_exp(o, vb3 + bm_ * (int)SHM_V, pa0, pa1, pa2, pa3, ol, osel, pB0, pB1, negb2);
      FSM(pB0, pB1, alB); SBAR();
      pv_d0<FIXM>(o, vb3 + b0_ * (int)SHM_V, pa0, pa1, pa2, pa3, &ol, osel); }
#undef DMA3
#undef VMW0
  } else {
  SLOAD(SE, 0); asm volatile("s_waitcnt vmcnt(0)" ::: "memory"); SWRITE(0, SE); __syncthreads();
  qkt(pA0, pA1, K_lds, qr, r32, hi); hook(pA0, pA1, 0, wid, r32, hi); PSM(pA0, pA1, mnA, alA);
  SLOAD(SO, KVBLK); if constexpr (SDEPTH == 2) { if (2 < NT) SLOAD(SE, 2 * KVBLK); }
  SWAIT(); SWRITE(1, SO); __syncthreads();
  for (int j = 1; j + 1 < NT; j += 2) {
    SBAR(); qkt(pB0, pB1, (bf16*)((char*)K_lds + SHM_K), qr, r32, hi);
    FSM(pA0, pA1, alA); SBAR();
    if (!ODDNT || j + SDEPTH < NT) SLOAD(SO, (j + SDEPTH) * KVBLK); SBAR();
    pv_d0<FIXM>(o, vb0, pa0, pa1, pa2, pa3, &ol, osel); hook(pB0, pB1, j, wid, r32, hi); PSM(pB0, pB1, mnB, alB);
    __syncthreads(); SWAIT(); SWRITE(0, SE);
    RESCF(alB); __syncthreads();
    SBAR(); qkt(pA0, pA1, K_lds, qr, r32, hi);
    FSM(pB0, pB1, alB); SBAR();
    if (SDEPTH == 1 || j + 3 < NT) SLOAD(SE, (j + 1 + SDEPTH) * KVBLK); SBAR();
    pv_d0<FIXM>(o, vb0 + (int)SHM_V, pa0, pa1, pa2, pa3, &ol, osel); hook(pA0, pA1, j + 1, wid, r32, hi); PSM(pA0, pA1, mnA, alA);
    __syncthreads(); SWAIT(); SWRITE(1, SO);
    RESCF(alA); __syncthreads();
  }
  if constexpr (ODDNT) {
  FSM(pA0, pA1, alA); SBAR();
  pv_d0<FIXM>(o, vb0, pa0, pa1, pa2, pa3, &ol, osel);
  } else {
  SBAR(); qkt(pB0, pB1, (bf16*)((char*)K_lds + SHM_K), qr, r32, hi);
  FSM(pA0, pA1, alA); SBAR();
  pv_d0<FIXM>(o, vb0, pa0, pa1, pa2, pa3, &ol, osel); hook(pB0, pB1, NT - 1, wid, r32, hi); PSM(pB0, pB1, mnB, alB);
  __syncthreads(); RESCF(alB);
  FSM(pB0, pB1, alB); SBAR();
  pv_d0<FIXM>(o, vb0 + (int)SHM_V, pa0, pa1, pa2, pa3, &ol, osel);
  }
  }
  float rli[16];
  if constexpr (FIXM) { if ((lane & 7) == 0) { float* dst = li_l + 4 * (lane >> 4) + ((lane & 8) ? 16 : 0); dst[0] = ol[0]; dst[1] = ol[1]; dst[2] = ol[2]; dst[3] = ol[3]; } }
  else { if (hi == 0) li_l[r32] = l_reg; }
  asm volatile("s_waitcnt lgkmcnt(0)" ::: "memory");
#pragma unroll
  for (int r = 0; r < 16; ++r) rli[r] = __builtin_amdgcn_rcpf(li_l[crow(r, hi)]);
  bf16* Ow = Ob + (long)(wid * QBLK) * LDO;
  float sq[16];
#pragma unroll
  for (int r = 0; r < 16; ++r) { int orow = crow(r, hi); sq[r] = 0.f;
#pragma unroll
    for (int d0 = 0; d0 < 4; ++d0) { const float v = o[d0][r] * rli[r]; sq[r] += v * v; const unsigned u = __float_as_uint(v); Ow[(long)orow * LDO + d0 * 32 + r32] = (bf16)((u + 0x7fffu + ((u >> 16) & 1u)) >> 16); } }
  if (ssrow) {
    float s8[8], s4[4], s2[2], s1;
#pragma unroll
    for (int i = 0; i < 8; ++i) { const bool up = (r32 & 16) != 0; const float keep = up ? sq[i + 8] : sq[i], send = up ? sq[i] : sq[i + 8]; s8[i] = keep + __shfl_xor(send, 16); }
#pragma unroll
    for (int i = 0; i < 4; ++i) { const bool up = (r32 & 8) != 0; const float keep = up ? s8[i + 4] : s8[i], send = up ? s8[i] : s8[i + 4]; s4[i] = keep + __shfl_xor(send, 8); }
#pragma unroll
    for (int i = 0; i < 2; ++i) { const bool up = (r32 & 4) != 0; const float keep = up ? s4[i + 2] : s4[i], send = up ? s4[i] : s4[i + 2]; s2[i] = keep + __shfl_xor(send, 4); }
    { const bool up = (r32 & 2) != 0; const float keep = up ? s2[1] : s2[0], send = up ? s2[0] : s2[1]; s1 = keep + __shfl_xor(send, 2); }
    s1 += __shfl_xor(s1, 1);
    if ((r32 & 1) == 0) __hip_atomic_fetch_add(ssrow + wid * QBLK + crow(r32 >> 1, hi), (unsigned long long)(s1 * 1048576.0f + 0.5f), __ATOMIC_RELAXED, __HIP_MEMORY_SCOPE_AGENT);
  }
#undef SLOAD
#undef SWRITE
#undef SWAIT
#undef RESC
#undef RESCF
#undef PSM
#undef FSM
}

__device__ __forceinline__ void partialSM1(f32x16& p0, float& m_reg, float& mn, float& alpha) {
  constexpr float C = SCALE * 1.4426950408889634f;
  float pmax = p0[0]; for (int r = 1; r < 16; ++r) pmax = fmaxf(pmax, p0[r]);
  { auto rr = __builtin_amdgcn_permlane32_swap(__float_as_uint(pmax), __float_as_uint(pmax), false, false);
    pmax = fmaxf(__uint_as_float(rr[0]), __uint_as_float(rr[1])); }
  if (__builtin_expect(__all(pmax - m_reg <= THR / SCALE), 1)) { mn = m_reg; alpha = 1.f; }
  else { mn = fmaxf(m_reg, pmax); alpha = __builtin_amdgcn_exp2f((m_reg - mn) * C); m_reg = mn; }
  float mnC = -mn * C;
  for (int r = 0; r < 16; ++r) p0[r] = fmaf(p0[r], C, mnC);
  for (int r = 0; r < 8; ++r) p0[r] = __builtin_amdgcn_exp2f(p0[r]);
}
__device__ __forceinline__ void finishSM1(f32x16& p0, float alpha, float& l_reg, bf16x8& pa0, bf16x8& pa1) {
  for (int r = 8; r < 16; ++r) p0[r] = __builtin_amdgcn_exp2f(p0[r]);
  float ps = 0; for (int r = 0; r < 16; ++r) ps += p0[r];
  { auto rr = __builtin_amdgcn_permlane32_swap(__float_as_uint(ps), __float_as_uint(ps), false, false);
    ps = __uint_as_float(rr[0]) + __uint_as_float(rr[1]); }
  l_reg = l_reg * alpha + ps;
#define PK4(P, BASE, OUT) do { unsigned a0 = cvtpk(P[BASE + 0], P[BASE + 1]), a1 = cvtpk(P[BASE + 2], P[BASE + 3]);   \
    unsigned b0 = cvtpk(P[BASE + 4], P[BASE + 5]), b1 = cvtpk(P[BASE + 6], P[BASE + 7]);                              \
    auto r0 = __builtin_amdgcn_permlane32_swap(a0, b0, false, false); auto r1 = __builtin_amdgcn_permlane32_swap(a1, b1, false, false); \
    u32x4 w = {r0[0], r1[0], r0[1], r1[1]}; OUT = *reinterpret_cast<bf16x8*>(&w); } while (0)
  PK4(p0, 0, pa0); PK4(p0, 8, pa1);
#undef PK4
}
__device__ __forceinline__ void qkt1(f32x16& p0, const bf16* Ks, const bf16x8* qr, int krow, int hi) {
  p0 = f32x16{};
  for (int d0 = 0; d0 < 8; ++d0) { int cb = (d0 * 16 + hi * 8) * 2;
    bf16x8 b0 = *reinterpret_cast<const bf16x8*>((const char*)Ks + KSWZ(krow, cb));
    p0 = __builtin_amdgcn_mfma_f32_32x32x16_bf16(b0, qr[d0], p0, 0, 0, 0); }
}
template <int D0> __device__ __forceinline__ void pv_one1(f32x16& od, int vb, bf16x8 pa0, bf16x8 pa1) {
  const s16x4 l0 = tr_read<v_rd_off(D0, 0, 0)>(vb), h0 = tr_read<v_rd_off(D0, 0, 1)>(vb), l1 = tr_read<v_rd_off(D0, 1, 0)>(vb), h1 = tr_read<v_rd_off(D0, 1, 1)>(vb);
  asm volatile("s_waitcnt lgkmcnt(0)" ::: "memory"); SBAR();
#define PK(L, H) (bf16x8){L[0], L[1], L[2], L[3], H[0], H[1], H[2], H[3]}
  od = __builtin_amdgcn_mfma_f32_32x32x16_bf16(pa0, PK(l0, h0), od, 0, 0, 0);
  od = __builtin_amdgcn_mfma_f32_32x32x16_bf16(pa1, PK(l1, h1), od, 0, 0, 0);
#undef PK
}
__device__ __forceinline__ void pv1(f32x16* o, int vb, bf16x8 pa0, bf16x8 pa1) { pv_one1<0>(o[0], vb, pa0, pa1); pv_one1<1>(o[1], vb, pa0, pa1); pv_one1<2>(o[2], vb, pa0, pa1); pv_one1<3>(o[3], vb, pa0, pa1); }

template <int LDK, int LDO, class QLoad, class Hook>
__device__ __forceinline__ void attn_natten_body(const QLoad& ql, const bf16* __restrict__ Kh, const bf16* __restrict__ Vh, bf16* __restrict__ Ob, int NT, char* lds, const Hook& hook, unsigned long long* ssrow) {
  constexpr int SDEPTH = 2;
  const int tid = opaque_tid(), wid = tid >> 6, lane = tid & 63, r32 = lane & 31, hi = lane >> 5;
  const int kb0 = wid < 3 ? 0 : (wid < 5 ? 16 : 32);
  bf16* V_lds = (bf16*)lds; bf16* K_lds = (bf16*)(lds + 2 * SHM_V);
  float* ws = (float*)(lds + 4 * SHM_V) + wid * 64; float* li_l = ws; float* al_l = ws + 32;
  float m_reg = -1e30f, l_reg = 0; f32x16 o[4] = {}; bf16x8 qr[8];
  { const int qrow = (r32 >> 3) * 64 + 8 * wid + (r32 & 7);
#pragma unroll
    for (int d0 = 0; d0 < 8; ++d0) qr[d0] = ql(qrow, hi * 8 + d0 * 16); }
  const int sr = tid >> 4, sc = (tid & 15) * 8, vst0 = v_st(sr, sc), vst1 = v_st(32 + sr, sc);
  const int vb0 = (int)(uintptr_t)V_lds + v_rd_base(lane) + (kb0 >> 4) * 4096, krow = kb0 + r32;
  struct { bf16x8 vs0, vs1, ks0, ks1; } sr_[SDEPTH];
#define SLOAD(i, k0) do { sr_[i].vs0 = ld8(&Vh[(long)((k0) + sr) * LDK + sc]); sr_[i].vs1 = ld8(&Vh[(long)((k0) + 32 + sr) * LDK + sc]); \
    sr_[i].ks0 = ld8(&Kh[(long)((k0) + sr) * LDK + sc]); sr_[i].ks1 = ld8(&Kh[(long)((k0) + 32 + sr) * LDK + sc]); } while (0)
#define SWRITE(b, i) do { *(bf16x8*)((char*)V_lds + (b) * SHM_V + vst0) = sr_[i].vs0;          \
    *(bf16x8*)((char*)V_lds + (b) * SHM_V + vst1) = sr_[i].vs1; int kc = sc * 2;               \
    *(bf16x8*)((char*)K_lds + (b) * SHM_K + KSWZ(sr, kc)) = sr_[i].ks0;                       \
    *(bf16x8*)((char*)K_lds + (b) * SHM_K + KSWZ(32 + sr, kc)) = sr_[i].ks1; } while (0)
#define SWAIT() asm volatile("s_waitcnt vmcnt(4)" ::: "memory")
#define RESC(a) do { if (__any((a) < 1.f)) { if (hi == 0) al_l[r32] = (a); asm volatile("s_waitcnt lgkmcnt(0)" ::: "memory"); \
    for (int d = 0; d < 4; ++d) for (int r = 0; r < 16; ++r) o[d][r] *= al_l[crow(r, hi)]; } } while (0)
  f32x16 pA, pB; float mnA, mnB, alA, alB; bf16x8 pa0, pa1;
  constexpr int SE = 0, SO = 1;
  SLOAD(SE, 0); asm volatile("s_waitcnt vmcnt(0)" ::: "memory"); SWRITE(0, SE); __syncthreads();
  qkt1(pA, K_lds, qr, krow, hi); hook(pA, 0); partialSM1(pA, m_reg, mnA, alA);
  SLOAD(SO, KVBLK); if (2 < NT) SLOAD(SE, 2 * KVBLK);
  SWAIT(); SWRITE(1, SO); __syncthreads();
  for (int j = 1; j + 1 < NT; j += 2) {
    SBAR(); qkt1(pB, (bf16*)((char*)K_lds + SHM_K), qr, krow, hi);
    finishSM1(pA, alA, l_reg, pa0, pa1); SBAR();
    if (j + 2 < NT) SLOAD(SO, (j + 2) * KVBLK); SBAR();
    pv1(o, vb0, pa0, pa1); hook(pB, j); partialSM1(pB, m_reg, mnB, alB);
    __syncthreads(); SWAIT(); SWRITE(0, SE);
    RESC(alB); __syncthreads();
    SBAR(); qkt1(pA, K_lds, qr, krow, hi);
    finishSM1(pB, alB, l_reg, pa0, pa1); SBAR();
    if (j + 3 < NT) SLOAD(SE, (j + 3) * KVBLK); SBAR();
    pv1(o, vb0 + (int)SHM_V, pa0, pa1); hook(pA, j + 1); partialSM1(pA, m_reg, mnA, alA);
    __syncthreads(); SWAIT(); SWRITE(1, SO);
    RESC(alA); __syncthreads();
  }
  finishSM1(pA, alA, l_reg, pa0, pa1); SBAR();
  pv1(o, vb0, pa0, pa1);
  if (hi == 0) li_l[r32] = l_reg;
  asm volatile("s_waitcnt lgkmcnt(0)" ::: "memory");
  float rli[16];
#pragma unroll
  for (int r = 0; r < 16; ++r) rli[r] = __builtin_amdgcn_rcpf(li_l[crow(r, hi)]);
  float sq[16];
#pragma unroll
  for (int r = 0; r < 16; ++r) { const int q = crow(r, hi), orow = (q >> 3) * 64 + 8 * wid + (q & 7); sq[r] = 0.f;
#pragma unroll
    for (int d0 = 0; d0 < 4; ++d0) { const float v = o[d0][r] * rli[r]; sq[r] += v * v; const unsigned u = __float_as_uint(v); Ob[(long)orow * LDO + d0 * 32 + r32] = (bf16)((u + 0x7fffu + ((u >> 16) & 1u)) >> 16); } }
  if (ssrow) {
    float s8[8], s4[4], s2[2], s1;
#pragma unroll
    for (int i = 0; i < 8; ++i) { const bool up = (r32 & 16) != 0; const float keep = up ? sq[i + 8] : sq[i], send = up ? sq[i] : sq[i + 8]; s8[i] = keep + __shfl_xor(send, 16); }
#pragma unroll
    for (int i = 0; i < 4; ++i) { const bool up = (r32 & 8) != 0; const float keep = up ? s8[i + 4] : s8[i], send = up ? s8[i] : s8[i + 4]; s4[i] = keep + __shfl_xor(send, 8); }
#pragma unroll
    for (int i = 0; i < 2; ++i) { const bool up = (r32 & 4) != 0; const float keep = up ? s4[i + 2] : s4[i], send = up ? s4[i] : s4[i + 2]; s2[i] = keep + __shfl_xor(send, 4); }
    { const bool up = (r32 & 2) != 0; const float keep = up ? s2[1] : s2[0], send = up ? s2[0] : s2[1]; s1 = keep + __shfl_xor(send, 2); }
    s1 += __shfl_xor(s1, 1);
    { const int q = crow(r32 >> 1, hi); if ((r32 & 1) == 0) __hip_atomic_fetch_add(ssrow + (q >> 3) * 64 + 8 * wid + (q & 7), (unsigned long long)(s1 * 1048576.0f + 0.5f), __ATOMIC_RELAXED, __HIP_MEMORY_SCOPE_AGENT); }
  }
#undef SLOAD
#undef SWRITE
#undef SWAIT
#undef RESC
}
#undef KSWZ
#undef SBAR
}
constexpr int NWAVES = 8;
#ifndef ATT_SD
#define ATT_SD 1
#endif
#ifndef ATT_FIXM
#define ATT_FIXM true
#endif
#ifndef MK_PER_PHASE
#define MK_PER_PHASE 0
#endif

constexpr int S = 8192, DM = 4096, DFF = 11008, NL = 2;
constexpr int HD = 128, NHA = 16, NKVA = 4, NHB = 16, INC = 9216;
constexpr int C_QA = 0, C_KA = 2048, C_VA = 2560, C_QB = 3072, C_KB = 5120, C_VB = 7168;
constexpr int MEML = 256, NHM = 4, MEMW = 512;
constexpr float EPS = 1e-6f;
constexpr int NGU = 2 * DFF;
constexpr int PH_PER_LAYER = 11, NPH = 1 + PH_PER_LAYER * NL + 1;

constexpr size_t MiB = 1u << 20;
constexpr size_t WS_CTL = 0, CTL_ZERO_BYTES = 64 * 1024;
constexpr size_t SZ_GU = (size_t)NGU * DM * 2, SZ_D = (size_t)DM * DFF * 2, SZ_IN = (size_t)INC * DM * 2, SZ_OUT = (size_t)DM * DM * 2,
                 SZ_Q = (size_t)MEMW * DM * 2, SZ_KV = (size_t)2 * MEMW * DM * 2, SZ_O = (size_t)DM * MEMW * 2;
constexpr size_t LW_GU1 = 0, LW_D1 = LW_GU1 + SZ_GU, LW_IN = LW_D1 + SZ_D, LW_OUT = LW_IN + SZ_IN, LW_Q = LW_OUT + SZ_OUT, LW_KV = LW_Q + SZ_Q, LW_O = LW_KV + SZ_KV,
                 LW_GU2 = LW_O + SZ_O, LW_D2 = LW_GU2 + SZ_GU, LW_SIZE = LW_D2 + SZ_D;
constexpr size_t WS_W = 1 * MiB;
constexpr size_t WS_H = WS_W + NL * LW_SIZE;
constexpr size_t WS_ACT = WS_H + (size_t)S * DM * 2;
constexpr size_t WS_PROJ = WS_ACT + (size_t)S * DFF * 2;
constexpr size_t WS_OB = WS_PROJ + (size_t)S * INC * 2;
constexpr size_t WS_XO = WS_OB + (size_t)S * DM * 2;
constexpr size_t WS_MEMN = WS_XO + (size_t)S * MEMW * 2;
constexpr size_t WS_MKV = WS_MEMN + (size_t)NL * MEML * DM * 2;
constexpr size_t WS_SS = WS_MKV + (size_t)NL * MEML * NL * 2 * MEMW * 2;
constexpr size_t WS_WKV = WS_SS + (size_t)NL * 6 * S * 8;
constexpr size_t WS_XQP = WS_WKV + (size_t)NL * 2 * MEMW * DM * 2;
constexpr size_t WS_ROPE = WS_XQP + (size_t)4 * S * MEMW * 4;
constexpr size_t WS_END = WS_ROPE + 2 * 128 * 32 * 4;
static_assert(LW_SIZE % 256 == 0 && WS_H % 256 == 0 && WS_MKV % 256 == 0, "alignment");
constexpr int CW_BAR = 4096;

constexpr int RING_OFF = 0, RING_BYTES = 131072;
constexpr int TBL_OFF = 69632;
constexpr int LDSCTL_OFF = RING_BYTES, MISC_OFF = LDSCTL_OFF + 320, RS_OFF = LDSCTL_OFF + 1024;
constexpr int LDS_BYTES = 147456;
static_assert(att::SHM_ATTN <= TBL_OFF && TBL_OFF + 4096 <= RING_BYTES, "LDS map");

#define GAS __attribute__((address_space(1)))
#define LAS __attribute__((address_space(3)))
typedef unsigned short bf16;
typedef unsigned v4u __attribute__((ext_vector_type(4)));
typedef float f32x4 __attribute__((ext_vector_type(4)));
typedef short bf16x8 __attribute__((ext_vector_type(8)));
typedef GAS unsigned gu32;
typedef GAS unsigned long long gu64;
#define RLX_AGENT __ATOMIC_RELAXED, __HIP_MEMORY_SCOPE_AGENT
#define LDS_WAIT() asm volatile("s_waitcnt lgkmcnt(0)" ::: "memory")
#define VM_WAIT() asm volatile("s_waitcnt vmcnt(0)" ::: "memory")
__device__ __forceinline__ unsigned long long rt() { return __builtin_amdgcn_s_memrealtime(); }
__device__ __forceinline__ unsigned f2bf(float f) { unsigned u = __builtin_bit_cast(unsigned, f); return (u + 0x7fffu + ((u >> 16) & 1u)) >> 16; }
__device__ __forceinline__ unsigned pk2(float lo, float hi) { return f2bf(lo) | (f2bf(hi) << 16); }

#define XB_TMO      128
#define XB_XCNT(j)  (256  + 64 * (j))
#define XB_XSUB(j)  (1280 + 64 * (j))
#define XB_XGEN(j)  (2304 + 64 * (j))
#define XB_TOP      3328
#define XB_TOPGEN   3392
#define XCD_BAR_WORDS 3456
#define XB_SPIN_CAP (1u << 18)

__device__ __forceinline__ unsigned xb_ld(unsigned* p)              { return __hip_atomic_load(p, __ATOMIC_RELAXED, __HIP_MEMORY_SCOPE_AGENT); }
__device__ __forceinline__ unsigned xb_add(unsigned* p, unsigned v) { return __hip_atomic_fetch_add(p, v, __ATOMIC_RELAXED, __HIP_MEMORY_SCOPE_AGENT); }
__device__ __forceinline__ unsigned xb_xcc_id() { return (unsigned)__builtin_amdgcn_s_getreg((3 << 11) | 20) & 0xFu; }
#define XB_SPIN(cond, bar) do { unsigned _sp = 0; while (cond) { __builtin_amdgcn_s_sleep(1); \
    if ((++_sp & 255u) == 0u) { if (xb_ld(&(bar)[XB_TMO])) break; if (_sp > XB_SPIN_CAP) { atomicAdd(&(bar)[XB_TMO], 1u); break; } } } } while (0)

struct XcdBarrier {
    unsigned* bar; unsigned x;
    volatile LAS unsigned* st;
};

__device__ __forceinline__ XcdBarrier xcd_barrier_post(unsigned* bar, volatile LAS unsigned* st) {
    XcdBarrier b; b.bar = bar; b.x = xb_xcc_id(); b.st = st;
    if (threadIdx.x == 0) (void)xb_add(&bar[XB_XCNT(b.x)], 1u);
    return b;
}
__device__ __forceinline__ void xcd_barrier_complete(unsigned* bar, unsigned x, unsigned& nloc, unsigned& nx) {
    const unsigned G = gridDim.x * gridDim.y * gridDim.z;
    unsigned sum, cnt, mine, sp = 0u;
    for (;;) {
        sum = 0u; cnt = 0u; mine = 0u;
#pragma unroll
        for (unsigned j = 0; j < 16; ++j) { const unsigned c = xb_ld(&bar[XB_XCNT(j)]); sum += c; cnt += (c > 0u) ? 1u : 0u; mine = (j == x) ? c : mine; }
        if (sum == G) break;
        __builtin_amdgcn_s_sleep(1);
        if ((++sp & 255u) == 0u) { if (xb_ld(&bar[XB_TMO])) break; if (sp > XB_SPIN_CAP) { atomicAdd(&bar[XB_TMO], 1u); break; } }
    }
    nloc = mine > 0u ? mine : 1u; nx = cnt > 0u ? cnt : 1u;
}

__device__ __forceinline__ void xcd_barrier(const XcdBarrier& b) {
    asm volatile("s_waitcnt vmcnt(0)" ::: "memory");
    __syncthreads();
    if (threadIdx.x == 0) {
        unsigned* bar = b.bar;
        __builtin_amdgcn_s_waitcnt(0);
        unsigned nloc = b.st[0], nx = b.st[1];
        if (nloc == 0u) { xcd_barrier_complete(bar, b.x, nloc, nx); b.st[0] = nloc; b.st[1] = nx; }
        const unsigned old = xb_add(&bar[XB_XSUB(b.x)], 1u);
        const unsigned gen = old / nloc;
        if (old + 1u == (gen + 1u) * nloc) {
            __builtin_amdgcn_fence(__ATOMIC_RELEASE, "agent");
            asm volatile("s_waitcnt vmcnt(0)" ::: "memory");
            const unsigned og = xb_add(&bar[XB_TOP], 1u);
            const unsigned tg = og / nx;
            if (og + 1u == (tg + 1u) * nx) xb_add(&bar[XB_TOPGEN], 1u);
            else XB_SPIN(xb_ld(&bar[XB_TOPGEN]) == tg, bar);
            __builtin_amdgcn_fence(__ATOMIC_ACQUIRE, "agent");
            xb_add(&bar[XB_XGEN(b.x)], 1u);
            asm volatile("s_waitcnt vmcnt(0)" ::: "memory");
        } else {
            XB_SPIN(xb_ld(&bar[XB_XGEN(b.x)]) == gen, bar);
            __builtin_amdgcn_fence(__ATOMIC_ACQUIRE, "agent");
            asm volatile("s_waitcnt vmcnt(0)" ::: "memory");
        }
    }
    __syncthreads();
}

struct Frame {
    LAS unsigned char* lds;
    volatile LAS unsigned* MISC;
    gu32* ctl;
    int vcu, G;
};
__device__ __forceinline__ float wave_sum(float v) {
#pragma unroll
    for (int o = 1; o < 64; o <<= 1) v += __shfl_xor(v, o);
    return v;
}
__device__ __forceinline__ void transpose_item(const float* W, int K, int N, bf16* WT, int kb, int n0, int drow0, const float* gk, LAS float* scr, int lane) {
    const int k0 = 64 * kb;
    const float gl = gk ? gk[k0 + lane] : 1.0f;
#pragma unroll 8
    for (int i = 0; i < 32; ++i) { const int kk = 2 * i + (lane >> 5); scr[kk * 33 + (lane & 31)] = __builtin_nontemporal_load(W + (size_t)(k0 + kk) * N + n0 + (lane & 31)) * __shfl(gl, kk); }
    LDS_WAIT(); asm volatile("" ::: "memory");
    const int c = lane & 7;
#pragma unroll
    for (int j = 0; j < 4; ++j) { const int n = (lane >> 3) + 8 * j; const LAS float* s = scr + (8 * c) * 33 + n;
        v4u o; o.x = pk2(s[0 * 33], s[1 * 33]); o.y = pk2(s[2 * 33], s[3 * 33]); o.z = pk2(s[4 * 33], s[5 * 33]); o.w = pk2(s[6 * 33], s[7 * 33]);
        *(GAS v4u*)(WT + (size_t)(drow0 + n) * K + k0 + 8 * c) = o; }
    LDS_WAIT(); asm volatile("" ::: "memory");
}
constexpr int I_G = (DM / 64) * (DFF / 32), I_D = (DFF / 64) * (DM / 32), I_IN = (DM / 64) * (INC / 32), I_OUT = (DM / 64) * (DM / 32),
              I_Q = (DM / 64) * (MEMW / 32), I_KV = (DM / 64) * (2 * MEMW / 32), I_O = (MEMW / 64) * (DM / 32);
constexpr int ITEMS_LAYER = 6 * I_G + I_IN + I_OUT + I_Q + I_KV + I_O;
static_assert(I_G == I_D, "gate/up/down item counts");

struct Args { const float* in[24]; float* out; unsigned char* ws; int ph_lo, ph_hi; };

__device__ __forceinline__ void p0_prologue(Frame& F, const Args& args) {
    const int tid_ = opaque_tid(), lane_ = tid_ & 63, wave_ = __builtin_amdgcn_readfirstlane(tid_ >> 6); (void)tid_; (void)lane_; (void)wave_;
    LAS float* scr = (LAS float*)(F.lds + RING_OFF + wave_ * 16384);
    const int gw = F.vcu * NWAVES + wave_, NGW = F.G * NWAVES;
    for (int it = gw; it < NL * ITEMS_LAYER; it += NGW) {
        const int l = it / ITEMS_LAYER; int r = it - l * ITEMS_LAYER;
        unsigned char* wl = args.ws + WS_W + (size_t)l * LW_SIZE;
        const float* W; int K, N; bf16* WT; int mode = 0; const float* gk = nullptr;
        if (r < I_G) { W = args.in[3] + (size_t)l * DM * DFF; K = DM; N = DFF; WT = (bf16*)(wl + LW_GU1); mode = 1; gk = args.in[2] + (size_t)l * DM; }
        else if ((r -= I_G) < I_G) { W = args.in[4] + (size_t)l * DM * DFF; K = DM; N = DFF; WT = (bf16*)(wl + LW_GU1); mode = 2; gk = args.in[2] + (size_t)l * DM; }
        else if ((r -= I_G) < I_D) { W = args.in[5] + (size_t)l * DFF * DM; K = DFF; N = DM; WT = (bf16*)(wl + LW_D1); }
        else if ((r -= I_D) < I_IN) { W = args.in[7] + (size_t)l * DM * INC; K = DM; N = INC; WT = (bf16*)(wl + LW_IN); gk = args.in[6] + (size_t)l * DM; }
        else if ((r -= I_IN) < I_OUT) { W = args.in[13] + (size_t)l * DM * DM; K = DM; N = DM; WT = (bf16*)(wl + LW_OUT); mode = 3; }
        else if ((r -= I_OUT) < I_Q) { W = args.in[16] + (size_t)l * DM * MEMW; K = DM; N = MEMW; WT = (bf16*)(wl + LW_Q); gk = args.in[14] + (size_t)l * DM; }
        else if ((r -= I_Q) < I_KV) { W = args.in[17] + (size_t)l * DM * 2 * MEMW; K = DM; N = 2 * MEMW; WT = (bf16*)(args.ws + WS_WKV) + (size_t)l * 2 * MEMW * DM; }
        else if ((r -= I_KV) < I_O) { W = args.in[18] + (size_t)l * MEMW * DM; K = MEMW; N = DM; WT = (bf16*)(wl + LW_O); }
        else if ((r -= I_O) < I_G) { W = args.in[20] + (size_t)l * DM * DFF; K = DM; N = DFF; WT = (bf16*)(wl + LW_GU2); mode = 1; gk = args.in[19] + (size_t)l * DM; }
        else if ((r -= I_G) < I_G) { W = args.in[21] + (size_t)l * DM * DFF; K = DM; N = DFF; WT = (bf16*)(wl + LW_GU2); mode = 2; gk = args.in[19] + (size_t)l * DM; }
        else { r -= I_G; W = args.in[22] + (size_t)l * DFF * DM; K = DFF; N = DM; WT = (bf16*)(wl + LW_D2); }
        const int kblk = K / 64, kb = r % kblk, n0 = 32 * (r / kblk);
        const int drow0 = (mode == 0 || mode == 3) ? n0 : (256 * (n0 >> 7) + (n0 & 127) + (mode == 2 ? 128 : 0));
        if (mode == 3) gk = (kb < 32) ? args.in[11] + (size_t)l * 2048 : args.in[12] + (size_t)l * 2048 - 2048;
        transpose_item(W, K, N, WT, kb, n0, drow0, gk, scr, lane_);
    }
}
__device__ __forceinline__ void rms_rows_bf16(Frame& F, const float* X, const float* g, bf16* H, int nrows) {
    const int tid_ = opaque_tid(), lane_ = tid_ & 63, wave_ = __builtin_amdgcn_readfirstlane(tid_ >> 6); (void)tid_; (void)lane_; (void)wave_;
    const int gw = F.vcu * NWAVES + wave_, NGW = F.G * NWAVES;
    f32x4 gv[16];
#pragma unroll
    for (int j = 0; j < 16; ++j) gv[j] = ((const GAS f32x4*)g)[64 * j + lane_];
    for (int m = gw; m < nrows; m += NGW) {
        const GAS f32x4* xr = (const GAS f32x4*)(X + (size_t)m * DM) + lane_;
        f32x4 v[16]; float s = 0.f;
#pragma unroll
        for (int j = 0; j < 16; ++j) { v[j] = xr[64 * j]; s += (v[j].x * v[j].x + v[j].y * v[j].y) + (v[j].z * v[j].z + v[j].w * v[j].w); }
        const float rstd = 1.f / sqrtf(wave_sum(s) * (1.f / DM) + EPS);
        GAS unsigned long long* o8 = (GAS unsigned long long*)(H + (size_t)m * DM) + lane_;
#pragma unroll
        for (int j = 0; j < 16; ++j) { const f32x4 y = v[j] * rstd * gv[j]; o8[64 * j] = (unsigned long long)pk2(y.x, y.y) | ((unsigned long long)pk2(y.z, y.w) << 32); }
    }
}
__device__ __forceinline__ void xb_rows(Frame& F, const float* X, bf16* XB, unsigned long long* ss) {
    const int tid_ = opaque_tid(), lane_ = tid_ & 63, wave_ = __builtin_amdgcn_readfirstlane(tid_ >> 6);
    const int gw = F.vcu * NWAVES + wave_, NGW = F.G * NWAVES;
    for (int m = gw; m < S; m += NGW) {
        const GAS f32x4* xr = (const GAS f32x4*)(X + (size_t)m * DM) + lane_;
        f32x4 v[16]; float s = 0.f;
#pragma unroll
        for (int j = 0; j < 16; ++j) { v[j] = xr[64 * j]; s += (v[j].x * v[j].x + v[j].y * v[j].y) + (v[j].z * v[j].z + v[j].w * v[j].w); }
        s = wave_sum(s);
        if (lane_ == 0) ss[m] = (unsigned long long)(s * pg8::SS_FIX + 0.5f);
        GAS unsigned long long* o8 = (GAS unsigned long long*)(XB + (size_t)m * DM) + lane_;
#pragma unroll
        for (int j = 0; j < 16; ++j) o8[64 * j] = (unsigned long long)pk2(v[j].x, v[j].y) | ((unsigned long long)pk2(v[j].z, v[j].w) << 32);
    }
}
__device__ __forceinline__ void final_rows_f32(Frame& F, const bf16* XB, const float* g, float* O, int nrows, bool poison) {
    const int tid_ = opaque_tid(), lane_ = tid_ & 63, wave_ = __builtin_amdgcn_readfirstlane(tid_ >> 6);
    const int gw = F.vcu * NWAVES + wave_, NGW = F.G * NWAVES;
    for (int m = gw; m < nrows; m += NGW) {
        const GAS v4u* p = (const GAS v4u*)(XB + (size_t)m * DM) + lane_;
        v4u w[8]; float s = 0.f;
#pragma unroll
        for (int j = 0; j < 8; ++j) { w[j] = p[64 * j];
#pragma unroll
            for (int e = 0; e < 4; ++e) { const float lo = __uint_as_float(w[j][e] << 16), hi = __uint_as_float(w[j][e] & 0xffff0000u); s += lo * lo + hi * hi; } }
        float rstd = 1.f / sqrtf(wave_sum(s) * (1.f / DM) + EPS);
        if (poison) rstd = __builtin_nanf("");
#pragma unroll
        for (int j = 0; j < 8; ++j) { const float* gp = g + 512 * j + 8 * lane_; const f32x4 g0 = *(const GAS f32x4*)gp, g1 = *(const GAS f32x4*)(gp + 4);
            f32x4 o0, o1;
            o0[0] = __uint_as_float(w[j][0] << 16) * rstd * g0[0]; o0[1] = __uint_as_float(w[j][0] & 0xffff0000u) * rstd * g0[1]; o0[2] = __uint_as_float(w[j][1] << 16) * rstd * g0[2]; o0[3] = __uint_as_float(w[j][1] & 0xffff0000u) * rstd * g0[3];
            o1[0] = __uint_as_float(w[j][2] << 16) * rstd * g1[0]; o1[1] = __uint_as_float(w[j][2] & 0xffff0000u) * rstd * g1[1]; o1[2] = __uint_as_float(w[j][3] << 16) * rstd * g1[2]; o1[3] = __uint_as_float(w[j][3] & 0xffff0000u) * rstd * g1[3];
            GAS f32x4* op = (GAS f32x4*)(O + (size_t)m * DM + 512 * j + 8 * lane_); op[0] = o0; op[1] = o1; }
    }
}
constexpr float QPRE = ATT_PRESCALED ? att::SCALE * 1.4426950408889634f : 1.0f;
__device__ __forceinline__ void qk_prep(Frame& F, bf16* PROJ, const float* qg, const float* kg, const float* rope) {
    const int tid_ = opaque_tid(), lane_ = tid_ & 63, wave_ = __builtin_amdgcn_readfirstlane(tid_ >> 6); (void)tid_; (void)lane_; (void)wave_;
    LAS float* tab = (LAS float*)(F.lds + RING_OFF);
    for (int idx = tid_; idx < 2 * 128 * 32; idx += NWAVES * 64) tab[idx] = rope[idx];
    __syncthreads();
    const int gw = F.vcu * NWAVES + wave_, NGW = F.G * NWAVES;
    const int hsub = lane_ >> 4, axis = (lane_ >> 3) & 1, jp = lane_ & 7, eo = axis * 64 + 4 * jp;
    const f32x4 q1 = *(const GAS f32x4*)(qg + eo), q2 = *(const GAS f32x4*)(qg + eo + 32), k1 = *(const GAS f32x4*)(kg + eo), k2 = *(const GAS f32x4*)(kg + eo + 32);
    for (int it0 = gw; it0 < S * 5; it0 += 4 * NGW) {
        unsigned long long w1[4], w2[4];
#pragma unroll
        for (int j = 0; j < 4; ++j) { const int it = it0 + j * NGW; if (it < S * 5) { const int t = it / 5, grp = it - 5 * t, hh = grp * 4 + hsub;
            const GAS unsigned long long* p = (const GAS unsigned long long*)(PROJ + (size_t)t * INC + hh * HD + eo); w1[j] = p[0]; w2[j] = p[8]; } else { w1[j] = 0ull; w2[j] = 0ull; } }
#pragma unroll
        for (int j = 0; j < 4; ++j) { const int it = it0 + j * NGW; if (it >= S * 5) break;
            const int t = it / 5, grp = it - 5 * t, hh = grp * 4 + hsub;
            GAS unsigned long long* p = (GAS unsigned long long*)(PROJ + (size_t)t * INC + hh * HD + eo);
            float x1[4], x2[4];
            x1[0] = __uint_as_float((unsigned)w1[j] << 16); x1[1] = __uint_as_float((unsigned)w1[j] & 0xffff0000u); x1[2] = __uint_as_float((unsigned)(w1[j] >> 32) << 16); x1[3] = __uint_as_float((unsigned)(w1[j] >> 32) & 0xffff0000u);
            x2[0] = __uint_as_float((unsigned)w2[j] << 16); x2[1] = __uint_as_float((unsigned)w2[j] & 0xffff0000u); x2[2] = __uint_as_float((unsigned)(w2[j] >> 32) << 16); x2[3] = __uint_as_float((unsigned)(w2[j] >> 32) & 0xffff0000u);
            float ss = 0.f;
#pragma unroll
            for (int e = 0; e < 4; ++e) ss += x1[e] * x1[e] + x2[e] * x2[e];
            ss += __shfl_xor(ss, 1); ss += __shfl_xor(ss, 2); ss += __shfl_xor(ss, 4); ss += __shfl_xor(ss, 8);
            const float rstd = 1.f / sqrtf(ss * (1.f / HD) + EPS);
            const f32x4 g1 = grp < 4 ? q1 : k1, g2 = grp < 4 ? q2 : k2;
            const int pos = axis ? (t & 63) : (t >> 6);
            const LAS float* tc = tab + pos * 32 + 4 * jp;
            float o1[4], o2[4];
            const float qs = grp < 4 ? QPRE : 1.0f;
#pragma unroll
            for (int e = 0; e < 4; ++e) { const float y1 = x1[e] * rstd * g1[e] * qs, y2 = x2[e] * rstd * g2[e] * qs, c = tc[e], s = tc[4096 + e]; o1[e] = y1 * c - y2 * s; o2[e] = y2 * c + y1 * s; }
            p[0] = (unsigned long long)pk2(o1[0], o1[1]) | ((unsigned long long)pk2(o1[2], o1[3]) << 32);
            p[8] = (unsigned long long)pk2(o2[0], o2[1]) | ((unsigned long long)pk2(o2[2], o2[3]) << 32);
        }
    }
}
struct PartQ {
    const float* base; const unsigned long long* ss;
    __device__ __forceinline__ att::bf16x8 operator()(int r, int d) const {
        const float rs = pg8::rstd_of(ss, r); const float* p = base + (size_t)r * MEMW + d; f32x4 a = {0.f, 0.f, 0.f, 0.f}, b = {0.f, 0.f, 0.f, 0.f};
#pragma unroll
        for (int ks = 0; ks < 4; ++ks) { a += *(const f32x4*)(p + (size_t)ks * S * MEMW); b += *(const f32x4*)(p + (size_t)ks * S * MEMW + 4); }
        a *= rs; b *= rs;
        att::u32x4 w = {att::cvtpk(a[0], a[1]), att::cvtpk(a[2], a[3]), att::cvtpk(b[0], b[1]), att::cvtpk(b[2], b[3])}; return *reinterpret_cast<att::bf16x8*>(&w); }
};
struct NattenHook {
    const LAS float* tbl; int i0, kr0;
    __device__ __forceinline__ bool active(int tile, int w) const { const int i = i0 + (w >> 1), rs = min(max(i - 4, 0), 120); return (unsigned)(kr0 + tile - rs) < 8u; }
    __device__ __forceinline__ void operator()(att::f32x16& p0, att::f32x16& p1, int tile, int, int, int) const {
        const int t_ = opaque_tid(), wid = t_ >> 6, r32 = t_ & 31, hi = (t_ >> 5) & 1;
        const int i = i0 + (wid >> 1), cq = (wid & 1) * 32 + r32;
        const int rs = min(max(i - 4, 0), 120), cs = min(max(cq - 8, 0), 48), kr = kr0 + tile;
        const float NEG = -__builtin_inff();
        if ((unsigned)(kr - rs) >= 8u) {
#pragma unroll
            for (int r = 0; r < 16; ++r) { p0[r] = NEG; p1[r] = NEG; }
            return; }
        const LAS float* tp = tbl + ((kr - i + 7) * 31 + 15 - cq + 4 * hi);
        const int d0 = 4 * hi - cs;
#pragma unroll
        for (int g = 0; g < 4; ++g) {
            float bb[8];
#pragma unroll
            for (int q = 0; q < 4; ++q) { const int kcc = q + 8 * g; bb[2 * q] = tp[kcc]; bb[2 * q + 1] = tp[kcc + 32]; }
            asm volatile("" : "+v"(bb[0]), "+v"(bb[1]), "+v"(bb[2]), "+v"(bb[3]), "+v"(bb[4]), "+v"(bb[5]), "+v"(bb[6]), "+v"(bb[7]));
#pragma unroll
            for (int q = 0; q < 4; ++q) { const int r = 4 * g + q, kcc = q + 8 * g;
                const float s0 = p0[r] + bb[2 * q], s1 = p1[r] + bb[2 * q + 1];
                p0[r] = ((unsigned)(kcc + d0) < 16u) ? s0 : NEG; p1[r] = ((unsigned)(kcc + 32 + d0) < 16u) ? s1 : NEG; }
        }
    }
};

struct NattenHook2 {
    const LAS float* tbl; int i0, kr0;
    __device__ __forceinline__ void operator()(att::f32x16& p0, int tile) const {
        const int t_ = opaque_tid(), wid = t_ >> 6, r32 = t_ & 31, hi = (t_ >> 5) & 1;
        const int i = i0 + (r32 >> 3), cq = 8 * wid + (r32 & 7), kb0 = wid < 3 ? 0 : (wid < 5 ? 16 : 32);
        const int rs = min(max(i - 4, 0), 120), cs = min(max(cq - 8, 0), 48), kr = kr0 + tile;
        const float NEG = -__builtin_inff();
        const bool rowok = (unsigned)(kr - rs) < 8u;
        const LAS float* tp = tbl + ((kr - i + 7) * 31 + 15 - cq + kb0 + 4 * hi);
        const int d0 = kb0 + 4 * hi - cs;
#pragma unroll
        for (int g = 0; g < 4; ++g) {
            float bb[4];
#pragma unroll
            for (int q = 0; q < 4; ++q) bb[q] = tp[q + 8 * g];
            asm volatile("" : "+v"(bb[0]), "+v"(bb[1]), "+v"(bb[2]), "+v"(bb[3]));
#pragma unroll
            for (int q = 0; q < 4; ++q) { const int r = 4 * g + q, kcc = q + 8 * g; const float s0 = p0[r] + bb[q]; p0[r] = (rowok && (unsigned)(kcc + d0) < 16u) ? s0 : NEG; }
        }
    }
};

__device__ __forceinline__ int rs_fill(Frame& F, const pg8::StaticOrder& So, const unsigned long long* ss) {
    pg8::Unit u0; int pm0 = -1;
    if (So.next(0, u0)) { pm0 = u0.pm; const int t = opaque_tid(); if (t < 256) ((LAS float*)(F.lds + RS_OFF))[t] = pg8::rstd_of(ss, pm0 * 256 + t); }
    __syncthreads();
    return pm0;
}

__device__ __forceinline__ int rs_fill2(Frame& F, const pg8::StaticOrder& So, const unsigned long long* ssa, const unsigned long long* ssb) {
    pg8::Unit u0; int pm0 = -1;
    if (So.next(0, u0)) { pm0 = u0.pm; const int t = opaque_tid(); if (t < 256) { const float ra = pg8::rstd2k_of(ssa, pm0 * 256 + t), rb = pg8::rstd2k_of(ssb, pm0 * 256 + t);
        LAS float* tb = (LAS float*)(F.lds + RS_OFF); tb[t] = ra / rb; tb[256 + t] = rb; } }
    __syncthreads();
    return pm0;
}

__global__ void __launch_bounds__(NWAVES * 64, 2) mega_fwd(Args args) {
    extern __shared__ __attribute__((aligned(16))) unsigned char lds[];
    Frame F;
    F.lds = (LAS unsigned char*)lds;
    F.MISC = (volatile LAS unsigned*)(F.lds + MISC_OFF);
    F.G = gridDim.x; { const int bx = blockIdx.x; F.vcu = (F.G % 8 == 0) ? (bx % 8) * (F.G / 8) + bx / 8 : bx; }
    unsigned char* ws = args.ws;
    F.ctl = (gu32*)(ws + WS_CTL);
    for (int u = threadIdx.x; u < (LDS_BYTES - LDSCTL_OFF) / 4; u += NWAVES * 64) ((LAS unsigned*)(F.lds + LDSCTL_OFF))[u] = 0u;
    __syncthreads();
    XcdBarrier bar; bar.bar = (unsigned*)(F.ctl + CW_BAR); bar.x = 0; bar.st = nullptr;
    if (!MK_PER_PHASE) bar = xcd_barrier_post((unsigned*)(F.ctl + CW_BAR), F.MISC + 8);
#define GRID_BAR() do { if (MK_PER_PHASE) { if (threadIdx.x == 0) __hip_atomic_store(F.ctl + 0, 0xBADBA0u, RLX_AGENT); } else { xcd_barrier(bar); } } while (0)
    const int lo = args.ph_lo, hi = args.ph_hi;
#define IN(k) (lo <= (k) && (k) < hi)
#define SEAM(k) do { if (IN(k) && IN((k) + 1)) GRID_BAR(); } while (0)

    bf16* XB = (bf16*)(ws + WS_H); bf16* ACT = (bf16*)(ws + WS_ACT); bf16* PROJ = (bf16*)(ws + WS_PROJ); bf16* OB = (bf16*)(ws + WS_OB);
    float* XQP = (float*)(ws + WS_XQP); float* ROPE = (float*)(ws + WS_ROPE); bf16* XO = (bf16*)(ws + WS_XO); bf16* MEMN = (bf16*)(ws + WS_MEMN); bf16* MKV = (bf16*)(ws + WS_MKV);
    unsigned long long* SSQ = (unsigned long long*)(ws + WS_SS);
#define SS_OF(l_, k_) (SSQ + ((size_t)(l_) * 6 + (k_)) * S)

    if (IN(0)) {
        p0_prologue(F, args);
        xb_rows(F, args.in[0], XB, SS_OF(0, 0));
        for (int l = 0; l < NL; ++l) rms_rows_bf16(F, args.in[1], args.in[15] + (size_t)l * DM, MEMN + (size_t)l * MEML * DM, MEML);
        for (size_t i = (size_t)blockIdx.x * (NWAVES * 64) + opaque_tid(); i < (size_t)(NL * 6 - 1) * S; i += (size_t)F.G * NWAVES * 64) SSQ[S + i] = 0ull;
        for (int idx = (int)blockIdx.x * (NWAVES * 64) + opaque_tid(); idx < 128 * 32; idx += F.G * NWAVES * 64) { const int pos = idx >> 5, f = idx & 31;
            const float invf = powf(10000.f, -(float)f * (1.f / 32.f)); float sn, cs; sincosf((float)pos * invf, &sn, &cs); ROPE[idx] = cs; ROPE[4096 + idx] = sn; }
    }
    SEAM(0);

    for (int l = 0; l < NL; ++l) {
        const int pb = 1 + PH_PER_LAYER * l;
        unsigned char* wl = ws + WS_W + (size_t)l * LW_SIZE;
        const bool lastl = (l == NL - 1);

        if (IN(pb + 0)) { pg8::Gemm g{XB, (const bf16*)(wl + LW_GU1), S, NGU, DM, DM}; pg8::StaticOrder So; So.init(S, NGU, F.G, opaque_bid());
            const int rpm = rs_fill(F, So, SS_OF(l, 0)); pg8::EpiSwiglu E{ACT, DFF, SS_OF(l, 0), (const LAS float*)(F.lds + RS_OFF), rpm}; pg8::gemm_phase<pg8::EpiSwiglu, pg8::StaticOrder, true, true>(F.lds + RING_OFF, g, So, E);
            if (l == 0) {
                pg8::Gemm g2{MEMN, (const bf16*)(ws + WS_WKV), NL * MEML, NL * 2 * MEMW, DM, DM}; pg8::KvOrder Ko{(opaque_bid() + 64) % F.G};
                pg8::EpiBf16 E2{MKV, NL * 2 * MEMW, nullptr, nullptr, -1}; pg8::gemm_phase<pg8::EpiBf16, pg8::KvOrder, true, true>(F.lds + RING_OFF, g2, Ko, E2); } }
        SEAM(pb + 0);
        if (IN(pb + 1)) { pg8::Gemm g{ACT, (const bf16*)(wl + LW_D1), S, DM, DFF, DFF}; pg8::StaticOrder So; So.init(S, DM, F.G, opaque_bid());
            pg8::EpiResidBf E{XB, DM, 0.5f, SS_OF(l, 1)}; pg8::gemm_phase<pg8::EpiResidBf, pg8::StaticOrder, true, true>(F.lds + RING_OFF, g, So, E); }
        SEAM(pb + 1);
        if (IN(pb + 2)) { pg8::Gemm g{XB, (const bf16*)(wl + LW_IN), S, INC, DM, DM}; pg8::StaticOrder So; So.init(S, INC, F.G, opaque_bid());
            const int rpm = rs_fill(F, So, SS_OF(l, 1)); pg8::EpiBf16 E{PROJ, INC, SS_OF(l, 1), (const LAS float*)(F.lds + RS_OFF), rpm}; pg8::gemm_phase<pg8::EpiBf16, pg8::StaticOrder, true, true>(F.lds + RING_OFF, g, So, E); }
        SEAM(pb + 2);
        if (IN(pb + 3)) { qk_prep(F, PROJ, args.in[8] + (size_t)l * HD, args.in[9] + (size_t)l * HD, ROPE); __syncthreads(); }
        SEAM(pb + 3);
        if (IN(pb + 4)) {
            float negb2; { const int ln = opaque_tid() & 63; const float* gq = args.in[8] + (size_t)l * HD; const float* gk_ = args.in[9] + (size_t)l * HD;
                float mq = fmaxf(fabsf(gq[ln]), fabsf(gq[ln + 64])), mk = fmaxf(fabsf(gk_[ln]), fabsf(gk_[ln + 64]));
#pragma unroll
                for (int o_ = 1; o_ < 64; o_ <<= 1) { mq = fmaxf(mq, __shfl_xor(mq, o_)); mk = fmaxf(mk, __shfl_xor(mk, o_)); }
                float nb = -(11.313708499f * mq * mk * 1.03f) * 1.4426950408889634f; if (ATT_PRESCALED && nb > -60.f) nb = 0.f;
                negb2 = __builtin_bit_cast(float, __builtin_amdgcn_readfirstlane(__builtin_bit_cast(int, nb))); }
            for (int u = F.vcu; u < NHA * (S / 256); u += F.G) { const int h = u >> 5, qb = u & 31, kvh = h >> 2;
                att::attn_dense_body<INC, DM, ATT_SD, ATT_FIXM, att::BfQ, att::NoHook>(att::BfQ{PROJ + (size_t)qb * 256 * INC + C_QA + h * HD, INC}, PROJ + C_KA + kvh * HD, PROJ + C_VA + kvh * HD,
                                                                OB + (size_t)qb * 256 * DM + h * HD, S, (char*)lds + RING_OFF, att::NoHook{}, SS_OF(l, 4) + qb * 256, negb2);
                __syncthreads(); }
            for (int u = F.vcu; u < NHB * (S / 256); u += F.G) { const int h = u >> 5, blk = u & 31, i0 = 4 * blk, kr0 = min(max(i0 - 4, 0), 117);
                LAS float* tbl = (LAS float*)(F.lds + TBL_OFF + 256); const float* rp = args.in[10] + ((size_t)l * NHB + h) * 15 * 31;
                for (int i = opaque_tid(); i < 15 * 31; i += NWAVES * 64) tbl[i] = rp[i] * (1.0f / att::SCALE);
                __syncthreads();
                NattenHook2 hk{tbl, i0, kr0};
                att::attn_natten_body<INC, DM, att::BfQ, NattenHook2>(att::BfQ{PROJ + (size_t)blk * 256 * INC + C_QB + h * HD, INC}, PROJ + (size_t)kr0 * 64 * INC + C_KB + h * HD, PROJ + (size_t)kr0 * 64 * INC + C_VB + h * HD,
                                                               OB + (size_t)blk * 256 * DM + 2048 + h * HD, 11, (char*)lds + RING_OFF, hk, SS_OF(l, 5) + blk * 256);
                __syncthreads(); }
        }
        SEAM(pb + 4);
        if (IN(pb + 5)) { pg8::Gemm g{OB, (const bf16*)(wl + LW_OUT), S, DM, DM, DM}; pg8::StaticOrder So; So.init(S, DM, F.G, opaque_bid());
            const int tpm = rs_fill2(F, So, SS_OF(l, 4), SS_OF(l, 5));
            pg8::EpiResidMid E{XB, DM, SS_OF(l, 2), (const LAS float*)(F.lds + RS_OFF), tpm, SS_OF(l, 4), SS_OF(l, 5)}; pg8::gemm_phase<pg8::EpiResidMid, pg8::StaticOrder, true, true>(F.lds + RING_OFF, g, So, E); }
        SEAM(pb + 5);
        if (IN(pb + 6)) { pg8::Gemm g{XB, (const bf16*)(wl + LW_Q), S, MEMW, DM / 4, DM}; pg8::SplitK4Order So{F.vcu, F.G};
            pg8::EpiF32Part E{XQP, MEMW, (size_t)S * MEMW}; pg8::gemm_phase<pg8::EpiF32Part, pg8::SplitK4Order, true, true>(F.lds + RING_OFF, g, So, E); }
        SEAM(pb + 6);
        if (IN(pb + 7)) {
            for (int u = F.vcu; u < NHM * (S / 256); u += F.G) { const int h = u >> 5, qb = u & 31;
                PartQ ql{XQP + (size_t)qb * 256 * MEMW + h * HD, SS_OF(l, 2) + qb * 256};
                att::attn_dense_body<NL * 2 * MEMW, MEMW, 1, false, PartQ, att::NoHook>(ql, MKV + (size_t)l * MEML * (NL * 2 * MEMW) + l * 2 * MEMW + h * HD, MKV + (size_t)l * MEML * (NL * 2 * MEMW) + l * 2 * MEMW + MEMW + h * HD,
                                                                        XO + (size_t)qb * 256 * MEMW + h * HD, MEML, (char*)lds + RING_OFF, att::NoHook{});
                __syncthreads(); }
        }
        SEAM(pb + 7);
        if (IN(pb + 8)) { pg8::Gemm g{XO, (const bf16*)(wl + LW_O), S, DM, MEMW, MEMW}; pg8::StaticOrder So; So.init(S, DM, F.G, opaque_bid());
            pg8::EpiResidBf E{XB, DM, 1.0f, SS_OF(l, 3)}; pg8::gemm_phase<pg8::EpiResidBf, pg8::StaticOrder, true, true>(F.lds + RING_OFF, g, So, E); }
        SEAM(pb + 8);
        if (IN(pb + 9)) { pg8::Gemm g{XB, (const bf16*)(wl + LW_GU2), S, NGU, DM, DM}; pg8::StaticOrder So; So.init(S, NGU, F.G, opaque_bid());
            const int rpm = rs_fill(F, So, SS_OF(l, 3)); pg8::EpiSwiglu E{ACT, DFF, SS_OF(l, 3), (const LAS float*)(F.lds + RS_OFF), rpm}; pg8::gemm_phase<pg8::EpiSwiglu, pg8::StaticOrder, true, true>(F.lds + RING_OFF, g, So, E); }
        SEAM(pb + 9);
        if (IN(pb + 10)) { pg8::Gemm g{ACT, (const bf16*)(wl + LW_D2), S, DM, DFF, DFF}; pg8::StaticOrder So; So.init(S, DM, F.G, opaque_bid());
            pg8::EpiResidBf E{XB, DM, 0.5f, lastl ? nullptr : SS_OF(lastl ? 0 : l + 1, 0)};
            pg8::gemm_phase<pg8::EpiResidBf, pg8::StaticOrder, true, true>(F.lds + RING_OFF, g, So, E); }
        SEAM(pb + 10);
    }
    if (IN(NPH - 1)) {
        bool poison = false;
        if (!MK_PER_PHASE) poison = __hip_atomic_load((gu32*)((unsigned*)(F.ctl + CW_BAR) + XB_TMO), RLX_AGENT) != 0u;
        final_rows_f32(F, XB, args.in[23], args.out, S, poison);
    }
#undef IN
#undef SEAM
#undef GRID_BAR
}

extern "C" void kernel_launch(void* const* d_in, const int* in_sizes, int n_in, void* d_out, int out_size, void* d_ws, size_t ws_size, hipStream_t stream) {
    static int grid = 0;
    if (grid == 0) {
        if (n_in != 24 || in_sizes[0] != S * DM || out_size != S * DM || ws_size < WS_END) { fprintf(stderr, "kernel_launch: shape mismatch: n_in %d in0 %d out %d ws %zu (need %zu)\n", n_in, n_in > 0 ? in_sizes[0] : -1, out_size, ws_size, (size_t)WS_END); grid = -1; return; }
        int dev = 0, cus = 0, per_cu = 0;
        if (hipGetDevice(&dev) != hipSuccess || hipDeviceGetAttribute(&cus, hipDeviceAttributeMultiprocessorCount, dev) != hipSuccess) { grid = -1; return; }
        if (hipFuncSetAttribute((const void*)mega_fwd, hipFuncAttributeMaxDynamicSharedMemorySize, LDS_BYTES) != hipSuccess) { fprintf(stderr, "kernel_launch: hipFuncSetAttribute failed\n"); grid = -1; return; }
        if (hipOccupancyMaxActiveBlocksPerMultiprocessor(&per_cu, (const void*)mega_fwd, NWAVES * 64, LDS_BYTES) != hipSuccess || per_cu < 1)
            fprintf(stderr, "kernel_launch: note: occupancy query reports %d workgroups per CU\n", per_cu);
        (void)hipGetLastError();
        grid = cus;
    }
    if (grid < 0) return;
    if (hipMemsetAsync((char*)d_ws + WS_CTL, 0, CTL_ZERO_BYTES, stream) != hipSuccess) { fprintf(stderr, "kernel_launch: memset failed\n"); return; }
    Args a{};
    for (int i = 0; i < 24; ++i) a.in[i] = (const float*)d_in[i];
    a.out = (float*)d_out; a.ws = (unsigned char*)d_ws;
#if MK_PER_PHASE
    for (int p = 0; p < NPH; ++p) { a.ph_lo = p; a.ph_hi = p + 1; hipLaunchKernelGGL(mega_fwd, dim3(grid), dim3(NWAVES * 64), LDS_BYTES, stream, a); }
#else
    a.ph_lo = 0; a.ph_hi = NPH; hipLaunchKernelGGL(mega_fwd, dim3(grid), dim3(NWAVES * 64), LDS_BYTES, stream, a);
#endif
    const hipError_t le = hipPeekAtLastError();
    if (le != hipSuccess) fprintf(stderr, "kernel_launch: launch failed: %s\n", hipGetErrorName(le));
}
```
